# Optimizing an MI355X kernel written in HIP

```python
import math
import jax, jax.numpy as jnp
from jax import lax
import numpy as np

D_MODEL = 4096
BATCH = 4
SEQ = 4096
DEPTH = 1

HEAD_DIM = 128
N_Q_HEADS = 16
N_KV_HEADS = 4
GQA_GROUP = N_Q_HEADS // N_KV_HEADS
ATTN_W = N_Q_HEADS * HEAD_DIM
KV_W = N_KV_HEADS * HEAD_DIM
WINDOW = 128
BLOCK = 128
N_BUCKETS = 32
MAX_DISTANCE = 128
GMLP_HEADS = 16
GMLP_HEAD_DIM = 128
GMLP_W = GMLP_HEADS * GMLP_HEAD_DIM
CHUNK = 128
MIX_W = ATTN_W + GMLP_W
IN_W = ATTN_W + 2 * KV_W + 2 * GMLP_W
D_FF = 4 * D_MODEL
EPS = 1e-6
NEG = -1e30

kernel_name = "hybrid_window_gqa_gmlp_block"


def rmsnorm(x, g):
    xf = x.astype(jnp.float32)
    y = xf * lax.rsqrt(jnp.mean(xf * xf, axis=-1, keepdims=True) + EPS)
    return (y * g.astype(jnp.float32)).astype(x.dtype)


def t5_bucket(rel):
    nb = N_BUCKETS // 2
    max_exact = nb // 2
    ret = (rel > 0).astype(np.int32) * nb
    n = np.abs(rel)
    large = max_exact + (np.log(np.maximum(n, 1).astype(np.float32) / max_exact)
                         / math.log(MAX_DISTANCE / max_exact) * (nb - max_exact)).astype(np.int32)
    large = np.minimum(large, nb - 1)
    return ret + np.where(n < max_exact, n, large)


def band_layout(seq):
    nblk = seq // BLOCK
    a = np.arange(BLOCK)[:, None]
    s = np.arange(3 * BLOCK)[None, :]
    rel = s - BLOCK - a
    blk = np.arange(nblk)[:, None, None]
    k_pos = (blk - 1) * BLOCK + s[None]
    valid = (k_pos >= 0) & (k_pos < seq) & (np.abs(rel)[None] <= WINDOW)
    return rel, valid


def banded(t, nblk):
    B, _, H, D = t.shape
    tp = jnp.pad(t, ((0, 0), (BLOCK, BLOCK), (0, 0), (0, 0)))
    tb = tp.reshape(B, nblk + 2, BLOCK, H, D)
    return jnp.concatenate([tb[:, :-2], tb[:, 1:-1], tb[:, 2:]], axis=2)


def windowed_gqa(q, k, v, q_gain, k_gain, rel_bias, sink):
    B, S, _ = q.shape
    nblk = S // BLOCK
    q = rmsnorm(q.reshape(B, S, N_Q_HEADS, HEAD_DIM), q_gain)
    k = rmsnorm(k.reshape(B, S, N_KV_HEADS, HEAD_DIM), k_gain)
    v = v.reshape(B, S, N_KV_HEADS, HEAD_DIM)
    qb = q.reshape(B, nblk, BLOCK, N_KV_HEADS, GQA_GROUP, HEAD_DIM)
    kb = banded(k, nblk)
    vb = banded(v, nblk)
    rel, valid = band_layout(S)
    bias = rel_bias[jnp.asarray(t5_bucket(rel))]
    bias = jnp.transpose(bias, (2, 0, 1)).reshape(N_KV_HEADS, GQA_GROUP, BLOCK, 3 * BLOCK)
    s = jnp.einsum('bnqkgd,bnskd->bnkgqs', qb, kb).astype(jnp.float32) * (HEAD_DIM ** -0.5)
    s = jnp.where(jnp.asarray(valid)[None, :, None, None], s + bias.astype(jnp.float32), NEG)
    sink_l = sink.astype(jnp.float32).reshape(N_KV_HEADS, GQA_GROUP)[:, :, None, None]
    m = jnp.maximum(jnp.max(s, axis=-1, keepdims=True), sink_l)
    p = jnp.exp(s - m)
    p = p / (jnp.sum(p, axis=-1, keepdims=True) + jnp.exp(sink_l - m))
    o = jnp.einsum('bnkgqs,bnskd->bnqkgd', p.astype(v.dtype), vb)
    return o.reshape(B, S, ATTN_W)


def spatial_gating(u, v, v_gain, w_s, b_s):
    B, S, _ = u.shape
    nchunk = S // CHUNK
    u = jax.nn.gelu(u)
    v = rmsnorm(jax.nn.gelu(v), v_gain)
    vc = v.reshape(B, nchunk, CHUNK, GMLP_HEADS, GMLP_HEAD_DIM)
    sv = jnp.einsum('hts,bcshd->bcthd', w_s, vc) + b_s.T[None, None, :, :, None]
    return u * sv.reshape(B, S, GMLP_W)


def setup_inputs(seed: int = 0) -> dict:
    key = jax.random.key(seed)
    ks = jax.random.split(key, 16)
    f = jnp.float32
    L = DEPTH
    nrm = lambda k, shape, sc: jax.random.normal(k, shape, f) * sc
    return {
        "x": nrm(ks[0], (BATCH, SEQ, D_MODEL), 1.0),
        "norm1": 1.0 + nrm(ks[1], (L, D_MODEL), 0.02),
        "w_in": nrm(ks[2], (L, D_MODEL, IN_W), D_MODEL ** -0.5),
        "q_gain": 1.0 + nrm(ks[3], (L, HEAD_DIM), 0.02),
        "k_gain": 1.0 + nrm(ks[4], (L, HEAD_DIM), 0.02),
        "rel_bias": nrm(ks[5], (N_BUCKETS, N_Q_HEADS), 0.5),
        "attn_sink": nrm(ks[6], (L, N_Q_HEADS), 0.5),
        "attn_out_gain": 1.0 + nrm(ks[7], (L, ATTN_W), 0.02),
        "gmlp_v_gain": 1.0 + nrm(ks[8], (L, GMLP_W), 0.02),
        "gmlp_w_s": nrm(ks[9], (L, GMLP_HEADS, CHUNK, CHUNK), CHUNK ** -0.5),
        "gmlp_b_s": 1.0 + nrm(ks[10], (L, GMLP_HEADS, CHUNK), 0.1),
        "gmlp_out_gain": 1.0 + nrm(ks[11], (L, GMLP_W), 0.02),
        "w_out": nrm(ks[12], (L, MIX_W, D_MODEL), MIX_W ** -0.5),
        "norm2": 1.0 + nrm(ks[13], (L, D_MODEL), 0.02),
        "w1": nrm(ks[14], (L, D_MODEL, D_FF), D_MODEL ** -0.5),
        "w2": nrm(ks[15], (L, D_FF, D_MODEL), D_FF ** -0.5),
    }


def reference(x, norm1, w_in, q_gain, k_gain, rel_bias, attn_sink, attn_out_gain,
              gmlp_v_gain, gmlp_w_s, gmlp_b_s, gmlp_out_gain, w_out, norm2, w1, w2):
    o_k = ATTN_W
    o_v = o_k + KV_W
    o_u = o_v + KV_W
    o_g = o_u + GMLP_W
    for l in range(DEPTH):
        h = rmsnorm(x, norm1[l])
        z = jnp.einsum('bsd,de->bse', h, w_in[l])
        a = windowed_gqa(z[..., :o_k], z[..., o_k:o_v], z[..., o_v:o_u],
                         q_gain[l], k_gain[l], rel_bias, attn_sink[l])
        g = spatial_gating(z[..., o_u:o_g], z[..., o_g:], gmlp_v_gain[l],
                           gmlp_w_s[l], gmlp_b_s[l])
        mix = jnp.concatenate([rmsnorm(a, attn_out_gain[l]), rmsnorm(g, gmlp_out_gain[l])], axis=-1)
        x = x + jnp.einsum('bse,ed->bsd', mix, w_out[l])
        h = rmsnorm(x, norm2[l])
        hid = jnp.square(jax.nn.relu(jnp.einsum('bsd,df->bsf', h, w1[l])))
        x = x + jnp.einsum('bsf,fd->bsd', hid, w2[l])
    return x
```

```cpp
#include <hip/hip_runtime.h>
#include <hip/hip_cooperative_groups.h>
#include <cstdio>
#include <cstdint>
namespace cg = cooperative_groups;

#ifndef MK_N_LAUNCHES
#define MK_N_LAUNCHES 1
#endif

#define LAS __attribute__((address_space(3)))
typedef unsigned short bf16_t;
typedef short bf16x8 __attribute__((ext_vector_type(8)));
typedef short s16x4 __attribute__((ext_vector_type(4)));
typedef float f32x4 __attribute__((ext_vector_type(4)));
typedef unsigned u32x4 __attribute__((ext_vector_type(4)));
typedef unsigned u32x2 __attribute__((ext_vector_type(2)));

__device__ __forceinline__ unsigned cvt_pk_bf16(float lo, float hi) { unsigned r; asm volatile("v_cvt_pk_bf16_f32 %0, %1, %2" : "=v"(r) : "v"(lo), "v"(hi)); return r; }
__device__ __forceinline__ float bf_lo(unsigned w) { return __uint_as_float(w << 16); }
__device__ __forceinline__ float bf_hi(unsigned w) { return __uint_as_float(w & 0xffff0000u); }
__device__ __forceinline__ float gelu_tanh(float x) {
    const float u = x * (0.7978845608028654f + 0.035677408136300125f * x * x);
    const float e = __builtin_amdgcn_exp2f(-2.885390081777927f * u);
    return x * __builtin_amdgcn_rcpf(1.0f + e);
}

namespace pg8 {
constexpr int BM = 256, BK = 64, HALF = 128, HTB = HALF * BK * 2, STAGE_BYTES = 8 * HTB, NXCD = 8, WGM = 4;
__host__ __device__ __forceinline__ int lds_byte(int r, int c) { const int st = (r >> 4) * 2 + (c >> 5), rr = r & 15, cc = c & 31, ob = rr * 64 + cc * 2; return st * 1024 + (ob ^ (((ob >> 9) & 1) << 5)); }
__host__ __device__ __forceinline__ void stage_rc(int b, int& R, int& C) { const int st = b / 1024, sb = b % 1024, swz = sb ^ (((sb >> 9) & 1) << 5); R = (st >> 1) * 16 + swz / 64; C = (st & 1) * 32 + (swz % 64) / 2; }
__host__ __device__ __forceinline__ int perm32(int rho) { const int n = rho >> 4, i = rho & 15; return 8 * (i >> 2) + 4 * n + (i & 3); }

struct Unit { int pm, pn; };
struct Gemm { const bf16_t* A; const bf16_t* Bt; int M, N, K, lda, ldb; };

struct StaticOrder {
    int nM, nN, nwg, G, c;
    __host__ __device__ void init(int M, int N, int G_, int c_) { nM = M / BM; nN = N / BM; nwg = nM * nN; G = G_; c = c_; }
    __host__ __device__ bool next(int i, Unit& u) const {
        const long L = (long)i * G + c; if (L >= nwg) return false;
        int wgid = (int)L; { const int q = nwg / NXCD, r = nwg % NXCD, xcd = wgid % NXCD, off = wgid / NXCD; wgid = (xcd < r ? xcd * (q + 1) : r * (q + 1) + (xcd - r) * q) + off; }
        const int nig = WGM * nN, gid = wgid / nig, fm = gid * WGM, gsz = (nM - fm) < WGM ? (nM - fm) : WGM;
        u.pm = fm + ((wgid % nig) % gsz); u.pn = (wgid % nig) / gsz; return true;
    }
    __device__ __forceinline__ void a_ready(const Unit&) const {}
    __device__ __forceinline__ void done(const Unit&) const {}
};

constexpr float EPS = 1e-6f;

__device__ __forceinline__ void store_rows_bf16(LAS unsigned char* lw, bf16_t* gp  , size_t ld8  , const u32x4& w0, const u32x4& w1, int fr, int fq, int rr, int cc) {
    *(LAS u32x4*)(lw + fr * 128 + (((0 + fq) ^ (fr & 7)) << 4)) = w0;
    *(LAS u32x4*)(lw + fr * 128 + (((4 + fq) ^ (fr & 7)) << 4)) = w1;
    const u32x4 a0 = *(const LAS u32x4*)(lw + rr * 128 + ((cc ^ (rr & 7)) << 4)), a1 = *(const LAS u32x4*)(lw + (rr + 8) * 128 + ((cc ^ (rr & 7)) << 4));
    *(u32x4*)gp = a0; *(u32x4*)(gp + ld8) = a1;
}
struct EpiZ {
    static constexpr bool PERM = true, AFTER_DRAIN = false, MID = false, COLS64 = true;
    bf16_t* O; int ldc; int gelu_from; float* vss; int vss_from; LAS unsigned char* lw;
    __device__ __forceinline__ void operator()(const f32x4 (&acc)[2][2][4][2], const Unit& u, int wr, int wc, int fr, int fq) const {
        const int lane = fq * 16 + fr, rr = lane >> 3, cc = lane & 7;
        const int row0 = u.pm * BM + wr * 64 + fr;
        bf16_t* gbase = O + (size_t)(u.pm * BM + wr * 64 + rr) * ldc + u.pn * BM + wc * 64 + 8 * cc;
        const bool act = (u.pn * BM >= gelu_from), vs = (u.pn * BM >= vss_from);
#pragma unroll
        for (int ai = 0; ai < 2; ++ai)
#pragma unroll
            for (int m = 0; m < 4; ++m) { const int row = row0 + ai * HALF + m * 16; float ssq = 0.f; u32x4 w[2];
#pragma unroll
                for (int bj = 0; bj < 2; ++bj) { f32x4 v0 = acc[ai][bj][m][0], v1 = acc[ai][bj][m][1];
                    if (act) { v0 = (f32x4){gelu_tanh(v0[0]), gelu_tanh(v0[1]), gelu_tanh(v0[2]), gelu_tanh(v0[3])}; v1 = (f32x4){gelu_tanh(v1[0]), gelu_tanh(v1[1]), gelu_tanh(v1[2]), gelu_tanh(v1[3])}; }
                    ssq += (v0[0] * v0[0] + v0[1] * v0[1]) + (v0[2] * v0[2] + v0[3] * v0[3]) + (v1[0] * v1[0] + v1[1] * v1[1]) + (v1[2] * v1[2] + v1[3] * v1[3]);
                    w[bj].x = cvt_pk_bf16(v0[0], v0[1]); w[bj].y = cvt_pk_bf16(v0[2], v0[3]); w[bj].z = cvt_pk_bf16(v1[0], v1[1]); w[bj].w = cvt_pk_bf16(v1[2], v1[3]); }
                store_rows_bf16(lw, gbase + (size_t)(ai * HALF + m * 16) * ldc, (size_t)8 * ldc, w[0], w[1], fr, fq, rr, cc);
                if (vs) { ssq += __shfl_xor(ssq, 16); ssq += __shfl_xor(ssq, 32); if (fq == 0) vss[(size_t)row * 32 + (u.pn - vss_from / BM) * 4 + wc] = ssq; } }
    }
};
struct EpiOut {
    static constexpr bool PERM = false, AFTER_DRAIN = false, MID = true, COLS64 = false;
    const float* x; float* out; bf16_t* xg; const float* g2; float* rss; const float* ss; int ldc, ldx; LAS unsigned char* lw;
    __device__ __forceinline__ void mid(f32x4 (&acc)[2][2][4][2], const Unit& u, int wr, int wc, int fr_, int fq_) const {
        int fr = fr_, fq = fq_; asm volatile("" : "+v"(fr), "+v"(fq));
        const int row0 = u.pm * BM + wr * 64 + fr;
#pragma unroll
        for (int ai = 0; ai < 2; ++ai)
#pragma unroll
            for (int m = 0; m < 4; ++m) { const int row = row0 + ai * HALF + m * 16;
                const f32x4 pa = *(const f32x4*)(ss + (size_t)row * 32 + 4 * fq), pg = *(const f32x4*)(ss + (size_t)row * 32 + 16 + 4 * fq);
                float sa = (pa[0] + pa[1]) + (pa[2] + pa[3]), sg = (pg[0] + pg[1]) + (pg[2] + pg[3]);
                sa += __shfl_xor(sa, 16); sa += __shfl_xor(sa, 32); sg += __shfl_xor(sg, 16); sg += __shfl_xor(sg, 32);
                const float f = sqrtf((sg * (1.0f / 2048.0f) + EPS) / (sa * (1.0f / 2048.0f) + EPS));
#pragma unroll
                for (int bj = 0; bj < 2; ++bj) { acc[ai][bj][m][0] = acc[ai][bj][m][0] * f; acc[ai][bj][m][1] = acc[ai][bj][m][1] * f; } }
    }
    __device__ __forceinline__ void operator()(const f32x4 (&acc)[2][2][4][2], const Unit& u, int wr, int wc, int fr, int fq) const {
        const int lane = fq * 16 + fr, rr = lane >> 3, cc = lane & 7;
        const int wofs = fr * 128, wx = fr & 7;
        const int rofs0 = rr * 128 + ((cc ^ (rr & 7)) << 4), rofs1 = (rr + 8) * 128 + ((cc ^ (rr & 7)) << 4);
        const int rowb = u.pm * BM + wr * 64 + rr, colb = u.pn * BM + wc * 32 + 4 * cc;
        f32x4 g2v[2];
#pragma unroll
        for (int bj = 0; bj < 2; ++bj) g2v[bj] = *(const f32x4*)(g2 + colb + bj * HALF);
#pragma unroll
        for (int q4 = 0; q4 < 4; ++q4) {
            const int ai = q4 >> 1, mb = (q4 & 1) * 2;
            f32x4 xv[2][2][2], pgv[2][2];
#pragma unroll
            for (int mm = 0; mm < 2; ++mm)
#pragma unroll
                for (int h = 0; h < 2; ++h) { const int row = rowb + ai * HALF + (mb + mm) * 16 + 8 * h;
                    pgv[mm][h] = *(const f32x4*)(ss + (size_t)row * 32 + 16 + 4 * (cc & 3));
#pragma unroll
                    for (int bj = 0; bj < 2; ++bj) xv[mm][bj][h] = *(const f32x4*)(x + (size_t)row * ldc + colb + bj * HALF); }
#pragma unroll
            for (int mm = 0; mm < 2; ++mm) { const int m = mb + mm; const int row0 = rowb + ai * HALF + m * 16;
                float rg[2], ssq[2];
#pragma unroll
                for (int h = 0; h < 2; ++h) { float sg = (pgv[mm][h][0] + pgv[mm][h][1]) + (pgv[mm][h][2] + pgv[mm][h][3]); sg += __shfl_xor(sg, 1); sg += __shfl_xor(sg, 2);
                    rg[h] = 1.0f / sqrtf(sg * (1.0f / 2048.0f) + EPS); ssq[h] = 0.f; }
#pragma unroll
                for (int bj = 0; bj < 2; ++bj) {
                    *(LAS f32x4*)(lw + wofs + (((0 + fq) ^ wx) << 4)) = acc[ai][bj][m][0];
                    *(LAS f32x4*)(lw + wofs + (((4 + fq) ^ wx) << 4)) = acc[ai][bj][m][1];
                    f32x4 av[2]; av[0] = *(const LAS f32x4*)(lw + rofs0); av[1] = *(const LAS f32x4*)(lw + rofs1);
#pragma unroll
                    for (int h = 0; h < 2; ++h) { const size_t row = (size_t)(row0 + 8 * h);
                        const f32x4 v = xv[mm][bj][h] + av[h] * rg[h];
                        ssq[h] += (v[0] * v[0] + v[1] * v[1]) + (v[2] * v[2] + v[3] * v[3]);
                        const f32x4 a = v * g2v[bj]; u32x2 w; w.x = cvt_pk_bf16(a[0], a[1]); w.y = cvt_pk_bf16(a[2], a[3]);
                        *(u32x2*)(xg + row * ldx + colb + bj * HALF) = w; }
                }
#pragma unroll
                for (int h = 0; h < 2; ++h) { float q = ssq[h]; q += __shfl_xor(q, 1); q += __shfl_xor(q, 2); q += __shfl_xor(q, 4);
                    if (cc == 0) (void)__hip_atomic_fetch_add(rss + (size_t)(row0 + 8 * h) * 16 + u.pn, q, __ATOMIC_RELAXED, __HIP_MEMORY_SCOPE_AGENT); }
            }
            asm volatile("" ::: "memory");
        }
    }
};
struct EpiHid {
    static constexpr bool PERM = true, AFTER_DRAIN = false, MID = false, COLS64 = true;
    bf16_t* H; const float* rss; int ldc; LAS unsigned char* lw;
    __device__ __forceinline__ void operator()(const f32x4 (&acc)[2][2][4][2], const Unit& u, int wr, int wc, int fr, int fq) const {
        const int lane = fq * 16 + fr, rr = lane >> 3, cc = lane & 7;
        const int row0 = u.pm * BM + wr * 64 + fr;
        bf16_t* gbase = H + (size_t)(u.pm * BM + wr * 64 + rr) * ldc + u.pn * BM + wc * 64 + 8 * cc;
        f32x4 pr[2][4];
#pragma unroll
        for (int ai = 0; ai < 2; ++ai)
#pragma unroll
            for (int m = 0; m < 4; ++m) pr[ai][m] = *(const f32x4*)(rss + (size_t)(row0 + ai * HALF + m * 16) * 16 + 4 * fq);
#pragma unroll
        for (int ai = 0; ai < 2; ++ai)
#pragma unroll
            for (int m = 0; m < 4; ++m) {
                float s = (pr[ai][m][0] + pr[ai][m][1]) + (pr[ai][m][2] + pr[ai][m][3]);
                s += __shfl_xor(s, 16); s += __shfl_xor(s, 32);
                const float r2 = 1.0f / sqrtf(s * (1.0f / 4096.0f) + EPS);
                u32x4 w[2];
#pragma unroll
                for (int bj = 0; bj < 2; ++bj) { f32x4 v0 = acc[ai][bj][m][0] * r2, v1 = acc[ai][bj][m][1] * r2;
#pragma unroll
                    for (int e = 0; e < 4; ++e) { const float a = fmaxf(v0[e], 0.f), b = fmaxf(v1[e], 0.f); v0[e] = a * a; v1[e] = b * b; }
                    w[bj].x = cvt_pk_bf16(v0[0], v0[1]); w[bj].y = cvt_pk_bf16(v0[2], v0[3]); w[bj].z = cvt_pk_bf16(v1[0], v1[1]); w[bj].w = cvt_pk_bf16(v1[2], v1[3]); }
                store_rows_bf16(lw, gbase + (size_t)(ai * HALF + m * 16) * ldc, (size_t)8 * ldc, w[0], w[1], fr, fq, rr, cc); }
    }
};
struct EpiFinal {
    static constexpr bool PERM = false, AFTER_DRAIN = false, MID = false, COLS64 = false;
    float* out; int ldc; const bf16_t* xn; int ldx; const float* g2; LAS unsigned char* lw;
    __device__ __forceinline__ void operator()(const f32x4 (&acc)[2][2][4][2], const Unit& u, int wr, int wc, int fr, int fq) const {
        const int lane = fq * 16 + fr, rr = lane >> 3, cc = lane & 7;
        const int wofs = fr * 128, wx = fr & 7;
        const int rofs0 = rr * 128 + ((cc ^ (rr & 7)) << 4), rofs1 = (rr + 8) * 128 + ((cc ^ (rr & 7)) << 4);
        const int rowb = u.pm * BM + wr * 64 + rr, colb = u.pn * BM + wc * 32 + 4 * cc;
        f32x4 ig[2];
#pragma unroll
        for (int bj = 0; bj < 2; ++bj) { const f32x4 gv = *(const f32x4*)(g2 + colb + bj * HALF); ig[bj] = (f32x4){__builtin_amdgcn_rcpf(gv[0]), __builtin_amdgcn_rcpf(gv[1]), __builtin_amdgcn_rcpf(gv[2]), __builtin_amdgcn_rcpf(gv[3])}; }
#pragma unroll
        for (int ai = 0; ai < 2; ++ai) {
            u32x2 xv[4][2][2];
#pragma unroll
            for (int m = 0; m < 4; ++m)
#pragma unroll
                for (int bj = 0; bj < 2; ++bj) { const bf16_t* g0 = xn + (size_t)(rowb + ai * HALF + m * 16) * ldx + colb + bj * HALF; xv[m][bj][0] = *(const u32x2*)g0; xv[m][bj][1] = *(const u32x2*)(g0 + (size_t)8 * ldx); }
#pragma unroll
            for (int m = 0; m < 4; ++m)
#pragma unroll
                for (int bj = 0; bj < 2; ++bj) {
                    float* g0 = out + (size_t)(rowb + ai * HALF + m * 16) * ldc + colb + bj * HALF;
                    *(LAS f32x4*)(lw + wofs + (((0 + fq) ^ wx) << 4)) = acc[ai][bj][m][0];
                    *(LAS f32x4*)(lw + wofs + (((4 + fq) ^ wx) << 4)) = acc[ai][bj][m][1];
                    const f32x4 a0 = *(const LAS f32x4*)(lw + rofs0), a1 = *(const LAS f32x4*)(lw + rofs1);
                    const u32x2 w0 = xv[m][bj][0], w1 = xv[m][bj][1];
                    const f32x4 x0 = (f32x4){bf_lo(w0.x), bf_hi(w0.x), bf_lo(w0.y), bf_hi(w0.y)} * ig[bj], x1 = (f32x4){bf_lo(w1.x), bf_hi(w1.x), bf_lo(w1.y), bf_hi(w1.y)} * ig[bj];
                    *(f32x4*)g0 = x0 + a0; *(f32x4*)(g0 + (size_t)8 * ldc) = x1 + a1;
                }
        }
    }
};

template <class Epi, class Sched, bool ALIGN_EPI = false, bool SP2 = false>
__device__ __forceinline__ void gemm_phase(LAS unsigned char* lds, const Gemm g, const Sched& S, const Epi& E) {
    const int tid = threadIdx.x, wid = __builtin_amdgcn_readfirstlane(tid >> 6), lane = tid & 63, wr = wid >> 2, wc = wid & 3, fr = lane & 15, fq = lane >> 4;
    const int K = g.K, nt = K / BK;
    unsigned voffA[2], voffB[2];
#pragma unroll
    for (int i = 0; i < 2; ++i) { int R, C; stage_rc(tid * 16 + i * 8192, R, C); const int Rq = Epi::PERM ? perm32(R & 31) : (R & 31); const int Rb = Epi::COLS64 ? (64 * (R >> 5) + Rq) : ((R & ~31) + Rq);
        voffA[i] = (unsigned)(R * g.lda + C) * 2u; voffB[i] = (unsigned)(Rb * g.ldb + C) * 2u; }
    const size_t kstep = (size_t)(BK * 2);
    const size_t hsA = (size_t)HALF * g.lda * 2, hsB = (size_t)(Epi::COLS64 ? 32 : HALF) * g.ldb * 2;
    const size_t tsA = 2 * hsA, tsB = (size_t)BM * g.ldb * 2;
    const unsigned ldsw = (unsigned)wid * 1024u;
    const int aoff = lds_byte(wr * 64 + fr, fq * 8), boff = lds_byte(wc * 32 + fr, fq * 8);
#define PG8_SA(b, h) (((b) * 2 + (h)) * HTB)
#define PG8_SB(b, h) ((4 + (b) * 2 + (h)) * HTB)
#define PG8_STAGE(bufoff, gbase, voff) do { _Pragma("unroll") for (int _i = 0; _i < 2; ++_i) \
        __builtin_amdgcn_global_load_lds((const unsigned*)((const char*)(gbase) + (voff)[_i]), (LAS unsigned*)(lds + (bufoff) + ldsw + _i * 8192), 16, 0, 0); } while (0)
#define PG8_LDA(dst, b, h) do { _Pragma("unroll") for (int m = 0; m < 4; ++m) _Pragma("unroll") for (int k = 0; k < 2; ++k) dst[m][k] = *(const LAS bf16x8*)(lds + PG8_SA(b, h) + aoff + m * 2048 + k * 1024); } while (0)
#define PG8_LDB(dst, b, h) do { _Pragma("unroll") for (int n = 0; n < 2; ++n) _Pragma("unroll") for (int k = 0; k < 2; ++k) dst[n][k] = *(const LAS bf16x8*)(lds + PG8_SB(b, h) + boff + n * 2048 + k * 1024); } while (0)
#define PG8_MMA(ai, bj, At, Bt) do { __builtin_amdgcn_s_setprio(3); _Pragma("unroll") for (int m = 0; m < 4; ++m) _Pragma("unroll") for (int n = 0; n < 2; ++n) _Pragma("unroll") for (int k = 0; k < 2; ++k) \
        acc[ai][bj][m][n] = __builtin_amdgcn_mfma_f32_16x16x32_bf16(Bt[n][k], At[m][k], acc[ai][bj][m][n], 0, 0, 0); __builtin_amdgcn_s_setprio(0); } while (0)
#define PG8_WAIT_V(n) asm volatile("s_waitcnt vmcnt(" #n ")" ::: "memory")
#define PG8_WAIT_L(n) asm volatile("s_waitcnt lgkmcnt(" #n ")" ::: "memory")
#define PG8_BAR __builtin_amdgcn_s_barrier()
#define PG8_SCHED __builtin_amdgcn_sched_barrier(0)
    Unit cur, nxt; int ui = 0;
    if (!S.next(0, cur)) return;
    f32x4 acc[2][2][4][2];
#pragma unroll
    for (int a = 0; a < 2; ++a)
#pragma unroll
        for (int b = 0; b < 2; ++b)
#pragma unroll
            for (int m = 0; m < 4; ++m)
#pragma unroll
                for (int n = 0; n < 2; ++n) acc[a][b][m][n] = (f32x4){0.f, 0.f, 0.f, 0.f};
    bf16x8 At[4][2], B0[2][2], B1[2][2];
    const char* cA = (const char*)g.A + (size_t)cur.pm * tsA; const char* cB = (const char*)g.Bt + (size_t)cur.pn * tsB;
    S.a_ready(cur);
    if constexpr (SP2) {
        PG8_STAGE(PG8_SB(0, 0), cB, voffB); PG8_STAGE(PG8_SB(0, 1), cB + hsB, voffB); PG8_STAGE(PG8_SA(0, 0), cA, voffA); PG8_STAGE(PG8_SA(0, 1), cA + hsA, voffA);
        if (wr == 1) PG8_BAR;
        PG8_WAIT_V(2); PG8_BAR;
        PG8_STAGE(PG8_SB(1, 0), cB + kstep, voffB); PG8_STAGE(PG8_SA(1, 0), cA + kstep, voffA); PG8_STAGE(PG8_SB(1, 1), cB + hsB + kstep, voffB);
        PG8_WAIT_V(6); PG8_BAR;
    } else {
        PG8_STAGE(PG8_SB(0, 0), cB, voffB); PG8_STAGE(PG8_SA(0, 0), cA, voffA); PG8_STAGE(PG8_SB(0, 1), cB + hsB, voffB); PG8_STAGE(PG8_SA(0, 1), cA + hsA, voffA);
        if (wr == 1) PG8_BAR;
        PG8_WAIT_V(4); PG8_BAR;
        PG8_STAGE(PG8_SB(1, 0), cB + kstep, voffB); PG8_STAGE(PG8_SA(1, 0), cA + kstep, voffA); PG8_STAGE(PG8_SB(1, 1), cB + hsB + kstep, voffB);
        PG8_WAIT_V(6); PG8_BAR;
    }
    for (;;) {
        const bool has_next = S.next(ui + 1, nxt);
        const char* nA = has_next ? (const char*)g.A + (size_t)nxt.pm * tsA : cA; const char* nB = has_next ? (const char*)g.Bt + (size_t)nxt.pn * tsB : cB;
        for (int t = 0; t < nt; t += 2) {
            const bool last = (t == nt - 2);
            const char* a1 = cA + (size_t)(t + 1) * kstep;
            const char* a2 = last ? nA : cA + (size_t)(t + 2) * kstep; const char* b2 = last ? nB : cB + (size_t)(t + 2) * kstep;
            const char* a3 = a2 + kstep; const char* b3 = b2 + kstep;
            if (last && has_next) S.a_ready(nxt);
            if constexpr (Epi::MID) { if (t == nt / 2) E.mid(acc, cur, wr, wc, fr, fq); }
            if constexpr (SP2) {
            PG8_LDB(B0, 0, 0); PG8_LDB(B1, 0, 1); PG8_SCHED; PG8_LDA(At, 0, 0); PG8_STAGE(PG8_SA(1, 1), a1 + hsA, voffA);
            PG8_WAIT_V(8); PG8_WAIT_L(0); PG8_BAR; PG8_MMA(0, 0, At, B0); PG8_MMA(0, 1, At, B1); PG8_BAR; PG8_SCHED;
            PG8_LDA(At, 0, 1); PG8_STAGE(PG8_SB(0, 0), b2, voffB); PG8_STAGE(PG8_SB(0, 1), b2 + hsB, voffB); PG8_STAGE(PG8_SA(0, 0), a2, voffA);
            PG8_WAIT_V(8); PG8_WAIT_L(0); PG8_BAR; PG8_MMA(1, 0, At, B0); PG8_MMA(1, 1, At, B1); PG8_BAR; PG8_SCHED;
            PG8_LDB(B0, 1, 0); PG8_LDB(B1, 1, 1); PG8_SCHED; PG8_LDA(At, 1, 0); PG8_STAGE(PG8_SA(0, 1), a2 + hsA, voffA);
            PG8_WAIT_V(8); PG8_WAIT_L(0); PG8_BAR; PG8_MMA(0, 0, At, B0); PG8_MMA(0, 1, At, B1); PG8_BAR; PG8_SCHED;
            PG8_LDA(At, 1, 1); PG8_STAGE(PG8_SB(1, 0), b3, voffB); PG8_STAGE(PG8_SB(1, 1), b3 + hsB, voffB); PG8_STAGE(PG8_SA(1, 0), a3, voffA);
            PG8_WAIT_V(8); PG8_WAIT_L(0); PG8_BAR; PG8_MMA(1, 0, At, B0); PG8_MMA(1, 1, At, B1); PG8_BAR; PG8_SCHED;
            } else {
            PG8_LDB(B0, 0, 0); PG8_SCHED; PG8_LDA(At, 0, 0); PG8_STAGE(PG8_SA(1, 1), a1 + hsA, voffA);
            PG8_WAIT_L(8); PG8_BAR; PG8_WAIT_L(0); PG8_MMA(0, 0, At, B0); PG8_BAR; PG8_SCHED;
            PG8_LDB(B1, 0, 1); PG8_STAGE(PG8_SB(0, 0), b2, voffB);
            PG8_BAR; PG8_WAIT_L(0); PG8_MMA(0, 1, At, B1); PG8_BAR;
            PG8_LDA(At, 0, 1); PG8_STAGE(PG8_SA(0, 0), a2, voffA);
            PG8_BAR; PG8_WAIT_L(0); PG8_MMA(1, 0, At, B0); PG8_BAR; PG8_SCHED;
            PG8_STAGE(PG8_SB(0, 1), b2 + hsB, voffB);
            PG8_WAIT_V(6); PG8_BAR; PG8_MMA(1, 1, At, B1); PG8_BAR;
            PG8_LDB(B0, 1, 0); PG8_SCHED; PG8_LDA(At, 1, 0); PG8_STAGE(PG8_SA(0, 1), a2 + hsA, voffA);
            PG8_WAIT_L(8); PG8_BAR; PG8_WAIT_L(0); PG8_MMA(0, 0, At, B0); PG8_BAR; PG8_SCHED;
            PG8_LDB(B1, 1, 1); PG8_STAGE(PG8_SB(1, 0), b3, voffB);
            PG8_BAR; PG8_WAIT_L(0); PG8_MMA(0, 1, At, B1); PG8_BAR;
            PG8_LDA(At, 1, 1); PG8_STAGE(PG8_SA(1, 0), a3, voffA);
            PG8_BAR; PG8_WAIT_L(0); PG8_MMA(1, 0, At, B0); PG8_BAR; PG8_SCHED;
            PG8_STAGE(PG8_SB(1, 1), b3 + hsB, voffB);
            PG8_WAIT_V(6); PG8_BAR; PG8_MMA(1, 1, At, B1); PG8_BAR;
            }
        }
        if constexpr (ALIGN_EPI) { if (wr == 0) PG8_BAR; }
        if constexpr (!Epi::AFTER_DRAIN) { E(acc, cur, wr, wc, fr, fq); S.done(cur); }
        if (!has_next) break;
#pragma unroll
        for (int a = 0; a < 2; ++a)
#pragma unroll
            for (int b = 0; b < 2; ++b)
#pragma unroll
                for (int m = 0; m < 4; ++m)
#pragma unroll
                    for (int n = 0; n < 2; ++n) acc[a][b][m][n] = (f32x4){0.f, 0.f, 0.f, 0.f};
        cur = nxt; cA = nA; cB = nB; ++ui;
        if constexpr (ALIGN_EPI) { if (wr == 1) PG8_BAR; }
    }
    PG8_WAIT_V(0);
    if constexpr (!ALIGN_EPI) { if (wr == 0) PG8_BAR; }
    PG8_BAR;
#undef PG8_SA
#undef PG8_SB
#undef PG8_STAGE
#undef PG8_LDA
#undef PG8_LDB
#undef PG8_MMA
#undef PG8_WAIT_V
#undef PG8_WAIT_L
#undef PG8_BAR
#undef PG8_SCHED
}
}

constexpr int NWAVES = 8;
constexpr int BATCH = 4, SEQ = 4096, D = 4096, M = BATCH * SEQ;
constexpr int INW = 7168, MIXW = 4096, FF = 16384;
constexpr int O_K = 2048, O_V = 2560, O_U = 3072, O_G = 5120;
constexpr int NBLK = SEQ / 128;
constexpr float EPS = 1e-6f;
constexpr size_t MiB = 1u << 20;
constexpr int LDK4 = D + 64, LDK16 = FF + 64;
constexpr size_t WS_BIAS = 1 * MiB;
constexpr size_t WS_SS = 2 * MiB;
constexpr size_t WS_RSS = 4 * MiB;
constexpr size_t WS_VSS = 8 * MiB;
constexpr size_t WS_WIN = 10 * MiB;
constexpr size_t WS_WOUT = 68 * MiB;
constexpr size_t WS_W1 = 101 * MiB;
constexpr size_t WS_W2 = 231 * MiB;
constexpr size_t WS_XN = 360 * MiB;
constexpr size_t WS_HID = 490 * MiB;
constexpr size_t WS_Z = 490 * MiB;
constexpr size_t WS_AG = 714 * MiB;
constexpr size_t WS_END = 1004 * MiB;
static_assert(WS_WIN + (size_t)INW * LDK4 * 2 <= WS_WOUT && WS_WOUT + (size_t)D * LDK4 * 2 <= WS_W1 && WS_W1 + (size_t)FF * LDK4 * 2 <= WS_W2 && WS_W2 + (size_t)D * LDK16 * 2 <= WS_XN, "ws map (weights)");
static_assert(WS_XN + (size_t)M * LDK4 * 2 <= WS_HID && WS_HID + (size_t)M * LDK16 * 2 <= WS_END && WS_Z + (size_t)M * INW * 2 <= WS_AG && WS_AG + (size_t)M * MIXW * 2 <= WS_END, "ws map (activations)");
constexpr int LDS_BYTES = 147456;

#define LDS_WAIT() asm volatile("s_waitcnt lgkmcnt(0)" ::: "memory")
__device__ __forceinline__ float wave_sum(float v) {
#pragma unroll
    for (int o = 1; o < 64; o <<= 1) v += __shfl_xor(v, o);
    return v;
}
__device__ __forceinline__ void p0_row_load(const float* __restrict__ xr, f32x4 (&v)[16], int lane) {
#pragma unroll
    for (int j = 0; j < 8; ++j) { v[2 * j] = __builtin_nontemporal_load((const f32x4*)(xr + 512 * j + 8 * lane)); v[2 * j + 1] = __builtin_nontemporal_load((const f32x4*)(xr + 512 * j + 8 * lane + 4)); }
}
__device__ __forceinline__ void p0_row_store(const f32x4 (&v)[16], const float* __restrict__ g, bf16_t* __restrict__ o, int lane) {
    float s = 0.f;
#pragma unroll
    for (int j = 0; j < 16; ++j) s += (v[j][0] * v[j][0] + v[j][1] * v[j][1]) + (v[j][2] * v[j][2] + v[j][3] * v[j][3]);
    const float r = 1.0f / sqrtf(wave_sum(s) * (1.0f / D) + EPS);
#pragma unroll
    for (int j = 0; j < 8; ++j) { const f32x4 g0 = *(const f32x4*)(g + 512 * j + 8 * lane), g1 = *(const f32x4*)(g + 512 * j + 8 * lane + 4);
        const f32x4 a = v[2 * j] * r * g0, b = v[2 * j + 1] * r * g1;
        u32x4 w; w.x = cvt_pk_bf16(a[0], a[1]); w.y = cvt_pk_bf16(a[2], a[3]); w.z = cvt_pk_bf16(b[0], b[1]); w.w = cvt_pk_bf16(b[2], b[3]);
        *(u32x4*)(o + 512 * j + 8 * lane) = w; }
}
__device__ __forceinline__ int t5_bucket_dev(int rel) {
    const int n = rel < 0 ? -rel : rel;
    const int large = 8 + (n >= 12) + (n >= 16) + (n >= 23) + (n >= 32) + (n >= 46) + (n >= 64) + (n >= 91);
    return (rel > 0 ? 16 : 0) + (n < 8 ? n : large);
}

namespace mixp {
constexpr int KSTR = 272;
constexpr int K_OFF = 0, V_OFF = 128 * KSTR, B_OFF = V_OFF + 32768, MIX_LDS = B_OFF + 1056;
__device__ __forceinline__ unsigned offb(unsigned row, unsigned ch) { return 256u * row + 16u * (ch ^ (((row & 3u) << 2) | ((row >> 2) & 3u))); }
__device__ __forceinline__ bf16x8 tr_frag(LAS unsigned char* vimg, int rbase, int c, int lane) {
    const unsigned fq = lane >> 4, q = (lane & 15) >> 2, p = lane & 3;
    const unsigned r0 = rbase + 4 * fq + q, r1 = r0 + 16;
    const s16x4 t0 = __builtin_amdgcn_ds_read_tr16_b64_v4i16((LAS s16x4*)(vimg + offb(r0, 2 * c + (p >> 1)) + 8 * (p & 1)));
    const s16x4 t1 = __builtin_amdgcn_ds_read_tr16_b64_v4i16((LAS s16x4*)(vimg + offb(r1, 2 * c + (p >> 1)) + 8 * (p & 1)));
    return __builtin_shufflevector(t0, t1, 0, 1, 2, 3, 4, 5, 6, 7);
}
__device__ __forceinline__ float sumsq8(u32x4 w) {
    const float a0 = bf_lo(w.x), a1 = bf_hi(w.x), a2 = bf_lo(w.y), a3 = bf_hi(w.y), a4 = bf_lo(w.z), a5 = bf_hi(w.z), a6 = bf_lo(w.w), a7 = bf_hi(w.w);
    return (a0 * a0 + a1 * a1) + (a2 * a2 + a3 * a3) + (a4 * a4 + a5 * a5) + (a6 * a6 + a7 * a7);
}
__device__ __forceinline__ u32x4 scale8(u32x4 w, float r, const float* __restrict__ g) {
    const f32x4 g0 = *(const f32x4*)g, g1 = *(const f32x4*)(g + 4);
    u32x4 o; o.x = cvt_pk_bf16(bf_lo(w.x) * r * g0[0], bf_hi(w.x) * r * g0[1]); o.y = cvt_pk_bf16(bf_lo(w.y) * r * g0[2], bf_hi(w.y) * r * g0[3]);
    o.z = cvt_pk_bf16(bf_lo(w.z) * r * g1[0], bf_hi(w.z) * r * g1[1]); o.w = cvt_pk_bf16(bf_lo(w.w) * r * g1[2], bf_hi(w.w) * r * g1[3]); return o;
}

struct MixArgs { const bf16_t* Z; const float* biasT; const float* qg; const float* kg; const float* sink; const float* vgain; const float* ws; const float* bs; bf16_t* AG; float* SS; const float* VSS; };

struct ConvJob { const float* w1; const float* w2; bf16_t* w1t; bf16_t* w2t; int next, stride; };
constexpr int CONV_BLOCKS = 2 * 32768;
__device__ __forceinline__ void conv_load(const ConvJob& J, int idx, f32x4 (&v)[8], int lane) {
    const bool second = idx >= 32768; const int r = idx & 32767;
    const float* W = second ? J.w2 : J.w1; const int N = second ? D : FF, nb = second ? 128 : 512;
    const int k0 = 64 * (r / nb), n0 = 32 * (r % nb);
    const float* p = W + (size_t)(k0 + 8 * (lane >> 3)) * N + n0 + 4 * (lane & 7);
#pragma unroll
    for (int i = 0; i < 8; ++i) v[i] = __builtin_nontemporal_load((const f32x4*)(p + (size_t)i * N));
}
__device__ __forceinline__ void conv_store(const ConvJob& J, int idx, const f32x4 (&v)[8], int lane) {
    const bool second = idx >= 32768; const int r = idx & 32767;
    bf16_t* WT = second ? J.w2t : J.w1t; const int ldt = second ? LDK16 : LDK4, nb = second ? 128 : 512;
    const int k0 = 64 * (r / nb), n0 = 32 * (r % nb);
    bf16_t* q = WT + (size_t)(n0 + 4 * (lane & 7)) * ldt + k0 + 8 * (lane >> 3);
#pragma unroll
    for (int j = 0; j < 4; ++j) { u32x4 o; o.x = cvt_pk_bf16(v[0][j], v[1][j]); o.y = cvt_pk_bf16(v[2][j], v[3][j]); o.z = cvt_pk_bf16(v[4][j], v[5][j]); o.w = cvt_pk_bf16(v[6][j], v[7][j]);
        __builtin_nontemporal_store(o, (u32x4*)(q + (size_t)j * ldt)); }
}
#define MIX_LDS_BARRIER() do { asm volatile("s_waitcnt lgkmcnt(0)" ::: "memory"); __builtin_amdgcn_s_barrier(); asm volatile("" ::: "memory"); } while (0)
constexpr int KV_BUF = V_OFF + 32768;
constexpr int BT_OFF = 2 * KV_BUF;
constexpr int RN_OFF = BT_OFF + 2048;
static_assert(RN_OFF + 1024 <= 147456, "mixer LDS map");

__device__ __forceinline__ void attn_stream(LAS unsigned char* lds, const MixArgs& A, ConvJob& J, int vcu, int G, int tid, int wid, int lane) {
    constexpr int NU = BATCH * NBLK * 16;
    constexpr float L2E = 1.4426950408889634f;
    const int fr = lane & 15, fq = lane >> 4, skey = tid >> 2, spart = tid & 3, arow = 16 * wid + fr;
    LAS float* bt = (LAS float*)(lds + BT_OFF);
    if (vcu >= NU) return;
    int u = vcu, h = u & 15, bb = u >> 4, b = bb / NBLK, blk = bb % NBLK;
    int kb = (blk == 0) ? 1 : 0, khi = (blk == NBLK - 1) ? 1 : 2;
    int bt_head = -1;
    u32x4 kr[4], vr[4], qraw[4];
#define ATT_LOADKV(b_, blk_, kb_, h_) do { const bf16_t* kp_ = A.Z + ((size_t)(b_) * SEQ + (size_t)((blk_) - 1 + (kb_)) * 128 + skey) * INW + O_K + ((h_) >> 2) * 128 + 8 * spart; \
        _Pragma("unroll") for (int i = 0; i < 4; ++i) { kr[i] = *(const u32x4*)(kp_ + 32 * i); vr[i] = *(const u32x4*)(kp_ + (O_V - O_K) + 32 * i); } } while (0)
#define ATT_LOADQ(b_, blk_, h_) do { const bf16_t* qp_ = A.Z + ((size_t)(b_) * SEQ + (size_t)(blk_) * 128 + arow) * INW + (h_) * 128 + 8 * fq; \
        _Pragma("unroll") for (int s = 0; s < 4; ++s) qraw[s] = *(const u32x4*)(qp_ + 32 * s); } while (0)
#define ATT_WRITEKV(buf_) do { float ss_ = 0.f; _Pragma("unroll") for (int i = 0; i < 4; ++i) ss_ += sumsq8(kr[i]); \
        ss_ += __shfl_xor(ss_, 1); ss_ += __shfl_xor(ss_, 2); \
        if (spart == 0) ((LAS float*)(lds + RN_OFF))[(buf_) * 128 + skey] = 1.0f / sqrtf(ss_ * (1.0f / 128.0f) + EPS); \
        _Pragma("unroll") for (int i = 0; i < 4; ++i) { *(LAS u32x4*)(lds + (buf_) * KV_BUF + K_OFF + skey * KSTR + (4 * i + spart) * 16) = kr[i]; \
            *(LAS u32x4*)(lds + (buf_) * KV_BUF + V_OFF + offb(skey, 4 * i + spart)) = vr[i]; } } while (0)
    ATT_LOADKV(b, blk, kb, h); ATT_LOADQ(b, blk, h);
    __syncthreads();
    ATT_WRITEKV(0);
    int buf = 0; bool first = true;
    bf16x8 qf[4]; float mrun = 0.f, lpart = 0.f, sinkv = 0.f; f32x4 oacc[8];
    for (;;) {
        if (first) {
            if (h != bt_head) { __syncthreads(); if (tid < 511) { const int idx = tid - 127; bt[tid] = (idx >= 0 && idx <= 256) ? A.biasT[h * 260 + idx] : -1e30f; } bt_head = h; }
            float ss = 0.f;
#pragma unroll
            for (int s = 0; s < 4; ++s) ss += sumsq8(qraw[s]);
            ss += __shfl_xor(ss, 16); ss += __shfl_xor(ss, 32);
            const float rn = (1.0f / sqrtf(ss * (1.0f / 128.0f) + EPS)) * 0.08838834764831845f;
#pragma unroll
            for (int s = 0; s < 4; ++s) {
                const f32x4 g0 = *(const f32x4*)(A.qg + 32 * s + 8 * fq) * *(const f32x4*)(A.kg + 32 * s + 8 * fq), g1 = *(const f32x4*)(A.qg + 32 * s + 8 * fq + 4) * *(const f32x4*)(A.kg + 32 * s + 8 * fq + 4);
                const u32x4 w = qraw[s]; u32x4 o;
                o.x = cvt_pk_bf16(bf_lo(w.x) * rn * g0[0], bf_hi(w.x) * rn * g0[1]); o.y = cvt_pk_bf16(bf_lo(w.y) * rn * g0[2], bf_hi(w.y) * rn * g0[3]);
                o.z = cvt_pk_bf16(bf_lo(w.z) * rn * g1[0], bf_hi(w.z) * rn * g1[1]); o.w = cvt_pk_bf16(bf_lo(w.w) * rn * g1[2], bf_hi(w.w) * rn * g1[3]);
                qf[s] = __builtin_bit_cast(bf16x8, o); }
            sinkv = A.sink[h]; mrun = sinkv; lpart = 0.f;
#pragma unroll
            for (int c = 0; c < 8; ++c) oacc[c] = (f32x4){0.f, 0.f, 0.f, 0.f};
        }
        MIX_LDS_BARRIER();
        int nkb = kb + 1, nu = u, nh = h, nb_ = b, nblk = blk, nkhi = khi; bool nfirst = false, nvalid = true;
        if (nkb > khi) { nu = u + G; nfirst = true;
            if (nu < NU) { nh = nu & 15; const int nbb = nu >> 4; nb_ = nbb / NBLK; nblk = nbb % NBLK; nkb = (nblk == 0) ? 1 : 0; nkhi = (nblk == NBLK - 1) ? 1 : 2; } else nvalid = false; }
        const bool last = (kb == khi);
        if (nvalid) ATT_LOADKV(nb_, nblk, nkb, nh);
        f32x4 cv[8]; const int cidx = J.next; const bool cdo = cidx < CONV_BLOCKS;
        if (cdo) conv_load(J, cidx, cv, lane);
        LAS unsigned char* kbase = lds + buf * KV_BUF + K_OFF; LAS unsigned char* vbase = lds + buf * KV_BUF + V_OFF;
        f32x4 sacc[8];
#pragma unroll
        for (int kt = 0; kt < 8; ++kt) { sacc[kt] = (f32x4){0.f, 0.f, 0.f, 0.f};
#pragma unroll
            for (int s = 0; s < 4; ++s) { const bf16x8 a = *(const LAS bf16x8*)(kbase + (16 * kt + fr) * KSTR + (32 * s + 8 * fq) * 2);
                sacc[kt] = __builtin_amdgcn_mfma_f32_16x16x32_bf16(a, qf[s], sacc[kt], 0, 0, 0); } }
        float bm = -1e30f;
        {
            const LAS float* btp = bt + (kb * 128 + 4 * fq - arow + 127);
            const LAS f32x4* rnp = (const LAS f32x4*)(lds + RN_OFF) + buf * 32 + fq;
#pragma unroll
            for (int kt = 0; kt < 8; ++kt) { const f32x4 rk = rnp[4 * kt];
#pragma unroll
                for (int j = 0; j < 4; ++j) { const float v = sacc[kt][j] * rk[j] + btp[16 * kt + j]; sacc[kt][j] = v; bm = fmaxf(bm, v); } }
        }
        bm = fmaxf(bm, __shfl_xor(bm, 16)); bm = fmaxf(bm, __shfl_xor(bm, 32));
        const float mnew = fmaxf(mrun, bm), alpha = __builtin_amdgcn_exp2f((mrun - mnew) * L2E);
        mrun = mnew; lpart *= alpha;
#pragma unroll
        for (int c = 0; c < 8; ++c) oacc[c] = oacc[c] * alpha;
        const float moff = mnew * L2E;
        bf16x8 pf[4];
#pragma unroll
        for (int ks = 0; ks < 4; ++ks) { float p[8];
#pragma unroll
            for (int j = 0; j < 4; ++j) { p[j] = __builtin_amdgcn_exp2f(sacc[2 * ks][j] * L2E - moff); p[4 + j] = __builtin_amdgcn_exp2f(sacc[2 * ks + 1][j] * L2E - moff); }
            lpart += ((p[0] + p[1]) + (p[2] + p[3])) + ((p[4] + p[5]) + (p[6] + p[7]));
            u32x4 w; w.x = cvt_pk_bf16(p[0], p[1]); w.y = cvt_pk_bf16(p[2], p[3]); w.z = cvt_pk_bf16(p[4], p[5]); w.w = cvt_pk_bf16(p[6], p[7]);
            pf[ks] = __builtin_bit_cast(bf16x8, w); }
#pragma unroll
        for (int ks = 0; ks < 4; ++ks)
#pragma unroll
            for (int c = 0; c < 8; ++c) { const bf16x8 a = tr_frag(vbase, 32 * ks, c, lane);
                oacc[c] = __builtin_amdgcn_mfma_f32_16x16x32_bf16(a, pf[ks], oacc[c], 0, 0, 0); }
        if (last) {
            float l = lpart; l += __shfl_xor(l, 16); l += __shfl_xor(l, 32);
            l += __builtin_amdgcn_exp2f((sinkv - mrun) * L2E);
            const float inv = 1.0f / l;
            const size_t tok = (size_t)b * SEQ + (size_t)blk * 128 + arow;
            bf16_t* op = A.AG + tok * MIXW + h * 128 + 4 * fq;
            float ssq = 0.f;
#pragma unroll
            for (int c = 0; c < 8; ++c) { const f32x4 o = oacc[c] * inv; ssq += (o[0] * o[0] + o[1] * o[1]) + (o[2] * o[2] + o[3] * o[3]);
                u32x2 w; w.x = cvt_pk_bf16(o[0], o[1]); w.y = cvt_pk_bf16(o[2], o[3]); *(u32x2*)(op + 16 * c) = w; }
            ssq += __shfl_xor(ssq, 16); ssq += __shfl_xor(ssq, 32);
            if (fq == 0) A.SS[tok * 32 + h] = ssq;
        }
        if (nvalid) {
            if (nfirst) ATT_LOADQ(nb_, nblk, nh);
            ATT_WRITEKV(buf ^ 1);
        }
        if (cdo) { conv_store(J, cidx, cv, lane); J.next = cidx + J.stride; }
        if (!nvalid) break;
        buf ^= 1; kb = nkb; u = nu; h = nh; b = nb_; blk = nblk; khi = nkhi; first = nfirst;
    }
#undef ATT_LOADKV
#undef ATT_LOADQ
#undef ATT_WRITEKV
}

__device__ __forceinline__ void gmlp_stream(LAS unsigned char* lds, const MixArgs& A, ConvJob& J, int vcu, int G, int tid, int wid, int lane) {
    constexpr int NU = BATCH * NBLK * 16;
    const int fr = lane & 15, fq = lane >> 4, skey = tid >> 2, spart = tid & 3, trow = 16 * wid + fr;
    if (vcu >= NU) return;
    int u = vcu, hh = u & 15, bb = u >> 4;
    u32x4 vr[4]; f32x4 pa, pb;
#define GM_LOADV(bb_, hh_) do { const size_t t_ = (size_t)(bb_) * 128 + skey; const bf16_t* vp_ = A.Z + t_ * INW + O_G + (hh_) * 128 + 8 * spart; \
        _Pragma("unroll") for (int i = 0; i < 4; ++i) vr[i] = *(const u32x4*)(vp_ + 32 * i); \
        pa = *(const f32x4*)(A.VSS + t_ * 32 + 8 * spart); pb = *(const f32x4*)(A.VSS + t_ * 32 + 8 * spart + 4); } while (0)
#define GM_WRITEV(buf_, hh_) do { float ss_ = ((pa[0] + pa[1]) + (pa[2] + pa[3])) + ((pb[0] + pb[1]) + (pb[2] + pb[3])); \
        ss_ += __shfl_xor(ss_, 1); ss_ += __shfl_xor(ss_, 2); const float rn_ = 1.0f / sqrtf(ss_ * (1.0f / 2048.0f) + EPS); \
        _Pragma("unroll") for (int i = 0; i < 4; ++i) *(LAS u32x4*)(lds + (buf_) * KV_BUF + V_OFF + offb(skey, 4 * i + spart)) = scale8(vr[i], rn_, A.vgain + (hh_) * 128 + 32 * i + 8 * spart); } while (0)
    GM_LOADV(bb, hh);
    __syncthreads();
    GM_WRITEV(0, hh);
    int buf = 0, w_head = -1; bf16x8 wf[4]; float bsv = 0.f;
    for (;;) {
        if (hh != w_head) {
            const float* wp = A.ws + ((size_t)hh * 128 + trow) * 128 + 4 * fq;
#pragma unroll
            for (int ks = 0; ks < 4; ++ks) { const f32x4 a = *(const f32x4*)(wp + 32 * ks), c = *(const f32x4*)(wp + 32 * ks + 16);
                u32x4 w; w.x = cvt_pk_bf16(a[0], a[1]); w.y = cvt_pk_bf16(a[2], a[3]); w.z = cvt_pk_bf16(c[0], c[1]); w.w = cvt_pk_bf16(c[2], c[3]);
                wf[ks] = __builtin_bit_cast(bf16x8, w); }
            bsv = A.bs[hh * 128 + trow]; w_head = hh;
        }
        MIX_LDS_BARRIER();
        const int nu = u + G; const bool nvalid = nu < NU; const int nhh = nu & 15, nbb = nu >> 4;
        if (nvalid) GM_LOADV(nbb, nhh);
        f32x4 cv[8]; const int cidx = J.next; const bool cdo = cidx < CONV_BLOCKS;
        if (cdo) conv_load(J, cidx, cv, lane);
        const size_t tok = (size_t)bb * 128 + trow;
        const bf16_t* up = A.Z + tok * INW + O_U + hh * 128 + 4 * fq;
        u32x2 uu[8];
#pragma unroll
        for (int c = 0; c < 8; ++c) uu[c] = *(const u32x2*)(up + 16 * c);
        LAS unsigned char* vbase = lds + buf * KV_BUF + V_OFF;
        f32x4 acc[8];
#pragma unroll
        for (int c = 0; c < 8; ++c) acc[c] = (f32x4){0.f, 0.f, 0.f, 0.f};
#pragma unroll
        for (int ks = 0; ks < 4; ++ks)
#pragma unroll
            for (int c = 0; c < 8; ++c) { const bf16x8 a = tr_frag(vbase, 32 * ks, c, lane);
                acc[c] = __builtin_amdgcn_mfma_f32_16x16x32_bf16(a, wf[ks], acc[c], 0, 0, 0); }
        bf16_t* op = A.AG + tok * MIXW + 2048 + hh * 128 + 4 * fq;
        float ssq = 0.f;
#pragma unroll
        for (int c = 0; c < 8; ++c) {
            f32x4 o; o[0] = bf_lo(uu[c].x) * (acc[c][0] + bsv); o[1] = bf_hi(uu[c].x) * (acc[c][1] + bsv); o[2] = bf_lo(uu[c].y) * (acc[c][2] + bsv); o[3] = bf_hi(uu[c].y) * (acc[c][3] + bsv);
            ssq += (o[0] * o[0] + o[1] * o[1]) + (o[2] * o[2] + o[3] * o[3]);
            u32x2 w; w.x = cvt_pk_bf16(o[0], o[1]); w.y = cvt_pk_bf16(o[2], o[3]); *(u32x2*)(op + 16 * c) = w; }
        ssq += __shfl_xor(ssq, 16); ssq += __shfl_xor(ssq, 32);
        if (fq == 0) A.SS[tok * 32 + 16 + hh] = ssq;
        if (cdo) { conv_store(J, cidx, cv, lane); J.next = cidx + J.stride; }
        if (!nvalid) break;
        GM_WRITEV(buf ^ 1, nhh);
        buf ^= 1; u = nu; hh = nhh; bb = nbb;
    }
#undef GM_LOADV
#undef GM_WRITEV
}
}

struct Args {
    const float *x, *norm1, *w_in, *q_gain, *k_gain, *rel_bias, *attn_sink, *attn_out_gain, *gmlp_v_gain, *gmlp_w_s, *gmlp_b_s, *gmlp_out_gain, *w_out, *norm2, *w1, *w2;
    float* out; unsigned char* ws; int ph_lo, ph_hi;
};
constexpr int N_PHASES = 7;

__global__ void __launch_bounds__(NWAVES * 64, 2) fwd_mega(Args args) {
    extern __shared__ __attribute__((aligned(16))) unsigned char lds_raw[];
    LAS unsigned char* lds = (LAS unsigned char*)lds_raw;
    const int tid = threadIdx.x, lane = tid & 63, wave = __builtin_amdgcn_readfirstlane(tid >> 6);
    const int G = gridDim.x, bx = blockIdx.x;
    const int vcu = (G % 8 == 0) ? (bx % 8) * (G / 8) + bx / 8 : bx;
    unsigned char* ws = args.ws;
    bf16_t* Win_t = (bf16_t*)(ws + WS_WIN); bf16_t* Wout_t = (bf16_t*)(ws + WS_WOUT); bf16_t* W1_t = (bf16_t*)(ws + WS_W1); bf16_t* W2_t = (bf16_t*)(ws + WS_W2);
    bf16_t* XN = (bf16_t*)(ws + WS_XN); bf16_t* Z = (bf16_t*)(ws + WS_Z); bf16_t* AG = (bf16_t*)(ws + WS_AG); bf16_t* HID = (bf16_t*)(ws + WS_HID);
    float* biasT = (float*)(ws + WS_BIAS); float* SS = (float*)(ws + WS_SS); float* RSS = (float*)(ws + WS_RSS); float* VSS = (float*)(ws + WS_VSS);
    const int lo = args.ph_lo, hi = args.ph_hi;
#define IN(k) (lo <= (k) && (k) < hi)
#define SEAM(k) do { if (IN(k) && IN((k) + 1)) cg::this_grid().sync(); } while (0)

    if (IN(0)) {
        const int gw = vcu * NWAVES + wave, NGW = G * NWAVES;
        constexpr int B_IN = (D / 64) * (INW / 32), B_OUT = (MIXW / 64) * (D / 32), NBLK0 = B_IN + B_OUT;
        auto blk_load = [&](int it, f32x4 (&v)[8]) {
            const bool second = it >= B_IN; const int r = second ? it - B_IN : it;
            const float* W = second ? args.w_out : args.w_in; const int N = second ? D : INW, nb = N / 32;
            const float* p = W + (size_t)(64 * (r / nb) + 8 * (lane >> 3)) * N + 32 * (r % nb) + 4 * (lane & 7);
#pragma unroll
            for (int i = 0; i < 8; ++i) v[i] = __builtin_nontemporal_load((const f32x4*)(p + (size_t)i * N));
        };
        auto blk_store = [&](int it, f32x4 (&v)[8]) {
            const bool second = it >= B_IN; const int r = second ? it - B_IN : it;
            bf16_t* WT = second ? Wout_t : Win_t; const int nb = (second ? D : INW) / 32;
            const int k0 = 64 * (r / nb) + 8 * (lane >> 3), n0 = 32 * (r % nb) + 4 * (lane & 7);
            if (second) {
                const float* gp = (k0 < 2048) ? args.attn_out_gain + k0 : args.gmlp_out_gain + (k0 - 2048);
                const f32x4 g0 = *(const f32x4*)gp, g1 = *(const f32x4*)(gp + 4);
#pragma unroll
                for (int i = 0; i < 4; ++i) { v[i] = v[i] * g0[i]; v[4 + i] = v[4 + i] * g1[i]; }
            }
            bf16_t* q = WT + (size_t)n0 * LDK4 + k0;
#pragma unroll
            for (int j = 0; j < 4; ++j) { u32x4 o; o.x = cvt_pk_bf16(v[0][j], v[1][j]); o.y = cvt_pk_bf16(v[2][j], v[3][j]); o.z = cvt_pk_bf16(v[4][j], v[5][j]); o.w = cvt_pk_bf16(v[6][j], v[7][j]);
                *(u32x4*)(q + (size_t)j * LDK4) = o; }
        };
        {
            f32x4 va[8], vb[8]; int it = gw;
            if (it < NBLK0) blk_load(it, va);
            while (it < NBLK0) {
                const int n1 = it + NGW; if (n1 < NBLK0) blk_load(n1, vb);
                blk_store(it, va);
                if (n1 >= NBLK0) break;
                const int n2 = n1 + NGW; if (n2 < NBLK0) blk_load(n2, va);
                blk_store(n1, vb);
                it = n2;
            }
        }
        {
            f32x4 va[16], vb[16]; int m = gw;
            if (m < M) p0_row_load(args.x + (size_t)m * D, va, lane);
            while (m < M) {
                const int m1 = m + NGW; if (m1 < M) p0_row_load(args.x + (size_t)m1 * D, vb, lane);
                p0_row_store(va, args.norm1, XN + (size_t)m * LDK4, lane);
                if (m1 >= M) break;
                const int m2 = m1 + NGW; if (m2 < M) p0_row_load(args.x + (size_t)m2 * D, va, lane);
                p0_row_store(vb, args.norm1, XN + (size_t)m1 * LDK4, lane);
                m = m2;
            }
        }
        for (int e = (vcu * NWAVES * 64 + tid) * 4; e < M * 16; e += G * NWAVES * 64 * 4) *(f32x4*)(RSS + e) = (f32x4){0.f, 0.f, 0.f, 0.f};
        if (bx == 0) for (int e = tid; e < 16 * 257; e += NWAVES * 64) { const int h = e / 257, idx = e % 257; biasT[h * 260 + idx] = args.rel_bias[t5_bucket_dev(idx - 128) * 16 + h]; }
    }
    SEAM(0);
    if (IN(1)) {
        pg8::Gemm g{XN, Win_t, M, INW, D, LDK4, LDK4}; pg8::StaticOrder S; S.init(M, INW, G, bx);
        pg8::EpiZ E{Z, INW, O_U, VSS, O_G, lds + pg8::STAGE_BYTES + wave * 2048};
        pg8::gemm_phase<pg8::EpiZ, pg8::StaticOrder, true, true>(lds, g, S, E);
    }
    SEAM(1);
    if (IN(2)) {
        const mixp::MixArgs A{Z, biasT, args.q_gain, args.k_gain, args.attn_sink, args.gmlp_v_gain, args.gmlp_w_s, args.gmlp_b_s, AG, SS, VSS};
        mixp::ConvJob J{args.w1, args.w2, W1_t, W2_t, vcu * NWAVES + wave, G * NWAVES};
        mixp::attn_stream(lds, A, J, vcu, G, tid, wave, lane);
        mixp::gmlp_stream(lds, A, J, vcu, G, tid, wave, lane);
        while (J.next < mixp::CONV_BLOCKS) { f32x4 cv[8]; mixp::conv_load(J, J.next, cv, lane); mixp::conv_store(J, J.next, cv, lane); J.next += J.stride; }
    }
    SEAM(2);
    if (IN(4)) {
        pg8::Gemm g{AG, Wout_t, M, D, MIXW, MIXW, LDK4}; pg8::StaticOrder S; S.init(M, D, G, bx);
        pg8::EpiOut E{args.x, args.out, XN, args.norm2, RSS, SS, D, LDK4, lds + pg8::STAGE_BYTES + wave * 2048};
        pg8::gemm_phase<pg8::EpiOut, pg8::StaticOrder, true, true>(lds, g, S, E);
    }
    SEAM(4);
    if (IN(5)) {
        pg8::Gemm g{XN, W1_t, M, FF, D, LDK4, LDK4}; pg8::StaticOrder S; S.init(M, FF, G, bx);
        pg8::EpiHid E{HID, RSS, LDK16, lds + pg8::STAGE_BYTES + wave * 2048};
        pg8::gemm_phase<pg8::EpiHid, pg8::StaticOrder, true, true>(lds, g, S, E);
    }
    SEAM(5);
    if (IN(6)) {
        pg8::Gemm g{HID, W2_t, M, D, FF, LDK16, LDK16}; pg8::StaticOrder S; S.init(M, D, G, bx);
        pg8::EpiFinal E{args.out, D, XN, LDK4, args.norm2, lds + pg8::STAGE_BYTES + wave * 2048};
        pg8::gemm_phase<pg8::EpiFinal, pg8::StaticOrder, true, true>(lds, g, S, E);
    }
#undef IN
#undef SEAM
}

extern "C" void kernel_launch(void* const* d_in, const int* in_sizes, int n_in, void* d_out, int out_size, void* d_ws, size_t ws_size, hipStream_t stream) {
    static int grid = 0;
    if (grid == 0) {
        if (n_in != 16 || in_sizes[0] != M * D || out_size != M * D || ws_size < WS_END) { fprintf(stderr, "kernel_launch: unexpected shapes (n_in %d, in0 %d, out %d, ws %zu); nothing launched\n", n_in, n_in > 0 ? in_sizes[0] : -1, out_size, ws_size); grid = -1; return; }
        int dev = 0, cus = 0, per_cu = 0;
        if (hipGetDevice(&dev) != hipSuccess || hipDeviceGetAttribute(&cus, hipDeviceAttributeMultiprocessorCount, dev) != hipSuccess) { grid = -1; return; }
        if (hipFuncSetAttribute((const void*)fwd_mega, hipFuncAttributeMaxDynamicSharedMemorySize, LDS_BYTES) != hipSuccess) { fprintf(stderr, "kernel_launch: hipFuncSetAttribute failed\n"); grid = -1; return; }
        if (hipOccupancyMaxActiveBlocksPerMultiprocessor(&per_cu, (const void*)fwd_mega, NWAVES * 64, LDS_BYTES) != hipSuccess || per_cu < 1) { fprintf(stderr, "kernel_launch: occupancy query says %d blocks/CU\n", per_cu); per_cu = 1; }
        (void)hipGetLastError();
        grid = cus;
    }
    if (grid < 0) return;
    Args a{};
    a.x = (const float*)d_in[0]; a.norm1 = (const float*)d_in[1]; a.w_in = (const float*)d_in[2]; a.q_gain = (const float*)d_in[3]; a.k_gain = (const float*)d_in[4];
    a.rel_bias = (const float*)d_in[5]; a.attn_sink = (const float*)d_in[6]; a.attn_out_gain = (const float*)d_in[7]; a.gmlp_v_gain = (const float*)d_in[8];
    a.gmlp_w_s = (const float*)d_in[9]; a.gmlp_b_s = (const float*)d_in[10]; a.gmlp_out_gain = (const float*)d_in[11]; a.w_out = (const float*)d_in[12];
    a.norm2 = (const float*)d_in[13]; a.w1 = (const float*)d_in[14]; a.w2 = (const float*)d_in[15];
    a.out = (float*)d_out; a.ws = (unsigned char*)d_ws;
#if MK_N_LAUNCHES == 1
    a.ph_lo = 0; a.ph_hi = N_PHASES;
    void* kargs[] = {&a};
    hipError_t e = hipLaunchCooperativeKernel((const void*)fwd_mega, dim3(grid), dim3(NWAVES * 64), kargs, LDS_BYTES, stream);
    if (e != hipSuccess) fprintf(stderr, "kernel_launch: cooperative launch failed: %s (grid %d)\n", hipGetErrorString(e), grid);
#else
    for (int ph = 0; ph < N_PHASES; ++ph) {
        a.ph_lo = ph; a.ph_hi = ph + 1;
        hipLaunchKernelGGL(fwd_mega, dim3(grid), dim3(NWAVES * 64), LDS_BYTES, stream, a);
    }
#endif
}
```

```cpp
#include <hip/hip_runtime.h>
#include <hip/hip_cooperative_groups.h>
#include <cstdio>
#include <cstdint>
namespace cg = cooperative_groups;

#ifndef MK_N_LAUNCHES
#define MK_N_LAUNCHES 1
#endif

#define LAS __attribute__((address_space(3)))
typedef unsigned short bf16_t;
typedef short bf16x8 __attribute__((ext_vector_type(8)));
typedef short s16x4 __attribute__((ext_vector_type(4)));
typedef float f32x4 __attribute__((ext_vector_type(4)));
typedef unsigned u32x4 __attribute__((ext_vector_type(4)));
typedef unsigned u32x2 __attribute__((ext_vector_type(2)));

__device__ __forceinline__ unsigned cvt_pk_bf16(float lo, float hi) { unsigned r; asm volatile("v_cvt_pk_bf16_f32 %0, %1, %2" : "=v"(r) : "v"(lo), "v"(hi)); return r; }
__device__ __forceinline__ float bf_lo(unsigned w) { return __uint_as_float(w << 16); }
__device__ __forceinline__ float bf_hi(unsigned w) { return __uint_as_float(w & 0xffff0000u); }
__device__ __forceinline__ float gelu_tanh(float x) {
    const float u = x * (0.7978845608028654f + 0.035677408136300125f * x * x);
    const float e = __builtin_amdgcn_exp2f(-2.885390081777927f * u);
    return x * __builtin_amdgcn_rcpf(1.0f + e);
}

namespace pg8 {
constexpr int BM = 256, BK = 64, HALF = 128, HTB = HALF * BK * 2, STAGE_BYTES = 8 * HTB, NXCD = 8, WGM = 4;
__host__ __device__ __forceinline__ int lds_byte(int r, int c) { const int st = (r >> 4) * 2 + (c >> 5), rr = r & 15, cc = c & 31, ob = rr * 64 + cc * 2; return st * 1024 + (ob ^ (((ob >> 9) & 1) << 5)); }
__host__ __device__ __forceinline__ void stage_rc(int b, int& R, int& C) { const int st = b / 1024, sb = b % 1024, swz = sb ^ (((sb >> 9) & 1) << 5); R = (st >> 1) * 16 + swz / 64; C = (st & 1) * 32 + (swz % 64) / 2; }
__host__ __device__ __forceinline__ int perm32(int rho) { const int n = rho >> 4, i = rho & 15; return 8 * (i >> 2) + 4 * n + (i & 3); }

struct Unit { int pm, pn; };
struct Gemm { const bf16_t* A; const bf16_t* Bt; int M, N, K, lda, ldb; };

struct StaticOrder {
    int nM, nN, nwg, G, c;
    __host__ __device__ void init(int M, int N, int G_, int c_) { nM = M / BM; nN = N / BM; nwg = nM * nN; G = G_; c = c_; }
    __host__ __device__ bool next(int i, Unit& u) const {
        const long L = (long)i * G + c; if (L >= nwg) return false;
        int wgid = (int)L; { const int q = nwg / NXCD, r = nwg % NXCD, xcd = wgid % NXCD, off = wgid / NXCD; wgid = (xcd < r ? xcd * (q + 1) : r * (q + 1) + (xcd - r) * q) + off; }
        const int nig = WGM * nN, gid = wgid / nig, fm = gid * WGM, gsz = (nM - fm) < WGM ? (nM - fm) : WGM;
        u.pm = fm + ((wgid % nig) % gsz); u.pn = (wgid % nig) / gsz; return true;
    }
    __device__ __forceinline__ void a_ready(const Unit&) const {}
    __device__ __forceinline__ void done(const Unit&) const {}
};

constexpr float EPS = 1e-6f;

__device__ __forceinline__ void store_rows_bf16(LAS unsigned char* lw, bf16_t* gp  , size_t ld8  , const u32x4& w0, const u32x4& w1, int fr, int fq, int rr, int cc) {
    *(LAS u32x4*)(lw + fr * 128 + (((0 + fq) ^ (fr & 7)) << 4)) = w0;
    *(LAS u32x4*)(lw + fr * 128 + (((4 + fq) ^ (fr & 7)) << 4)) = w1;
    const u32x4 a0 = *(const LAS u32x4*)(lw + rr * 128 + ((cc ^ (rr & 7)) << 4)), a1 = *(const LAS u32x4*)(lw + (rr + 8) * 128 + ((cc ^ (rr & 7)) << 4));
    *(u32x4*)gp = a0; *(u32x4*)(gp + ld8) = a1;
}
struct EpiZ {
    static constexpr bool PERM = true, AFTER_DRAIN = false, MID = false, COLS64 = true;
    bf16_t* O; int ldc; int gelu_from; float* vss; int vss_from; LAS unsigned char* lw;
    __device__ __forceinline__ void operator()(const f32x4 (&acc)[2][2][4][2], const Unit& u, int wr, int wc, int fr, int fq) const {
        const int lane = fq * 16 + fr, rr = lane >> 3, cc = lane & 7;
        const int row0 = u.pm * BM + wr * 64 + fr;
        bf16_t* gbase = O + (size_t)(u.pm * BM + wr * 64 + rr) * ldc + u.pn * BM + wc * 64 + 8 * cc;
        const bool act = (u.pn * BM >= gelu_from), vs = (u.pn * BM >= vss_from);
#pragma unroll
        for (int ai = 0; ai < 2; ++ai)
#pragma unroll
            for (int m = 0; m < 4; ++m) { const int row = row0 + ai * HALF + m * 16; float ssq = 0.f; u32x4 w[2];
#pragma unroll
                for (int bj = 0; bj < 2; ++bj) { f32x4 v0 = acc[ai][bj][m][0], v1 = acc[ai][bj][m][1];
                    if (act) { v0 = (f32x4){gelu_tanh(v0[0]), gelu_tanh(v0[1]), gelu_tanh(v0[2]), gelu_tanh(v0[3])}; v1 = (f32x4){gelu_tanh(v1[0]), gelu_tanh(v1[1]), gelu_tanh(v1[2]), gelu_tanh(v1[3])}; }
                    ssq += (v0[0] * v0[0] + v0[1] * v0[1]) + (v0[2] * v0[2] + v0[3] * v0[3]) + (v1[0] * v1[0] + v1[1] * v1[1]) + (v1[2] * v1[2] + v1[3] * v1[3]);
                    w[bj].x = cvt_pk_bf16(v0[0], v0[1]); w[bj].y = cvt_pk_bf16(v0[2], v0[3]); w[bj].z = cvt_pk_bf16(v1[0], v1[1]); w[bj].w = cvt_pk_bf16(v1[2], v1[3]); }
                store_rows_bf16(lw, gbase + (size_t)(ai * HALF + m * 16) * ldc, (size_t)8 * ldc, w[0], w[1], fr, fq, rr, cc);
                if (vs) { ssq += __shfl_xor(ssq, 16); ssq += __shfl_xor(ssq, 32); if (fq == 0) vss[(size_t)row * 32 + (u.pn - vss_from / BM) * 4 + wc] = ssq; } }
    }
};
struct EpiOut {
    static constexpr bool PERM = false, AFTER_DRAIN = false, MID = true, COLS64 = false;
    const float* x; float* out; bf16_t* xg; const float* g2; float* rss; const float* ss; int ldc, ldx; LAS unsigned char* lw;
    __device__ __forceinline__ void mid(f32x4 (&acc)[2][2][4][2], const Unit& u, int wr, int wc, int fr_, int fq_) const {
        int fr = fr_, fq = fq_; asm volatile("" : "+v"(fr), "+v"(fq));
        const int row0 = u.pm * BM + wr * 64 + fr;
#pragma unroll
        for (int ai = 0; ai < 2; ++ai)
#pragma unroll
            for (int m = 0; m < 4; ++m) { const int row = row0 + ai * HALF + m * 16;
                const f32x4 pa = *(const f32x4*)(ss + (size_t)row * 32 + 4 * fq), pg = *(const f32x4*)(ss + (size_t)row * 32 + 16 + 4 * fq);
                float sa = (pa[0] + pa[1]) + (pa[2] + pa[3]), sg = (pg[0] + pg[1]) + (pg[2] + pg[3]);
                sa += __shfl_xor(sa, 16); sa += __shfl_xor(sa, 32); sg += __shfl_xor(sg, 16); sg += __shfl_xor(sg, 32);
                const float f = sqrtf((sg * (1.0f / 2048.0f) + EPS) / (sa * (1.0f / 2048.0f) + EPS));
#pragma unroll
                for (int bj = 0; bj < 2; ++bj) { acc[ai][bj][m][0] = acc[ai][bj][m][0] * f; acc[ai][bj][m][1] = acc[ai][bj][m][1] * f; } }
    }
    __device__ __forceinline__ void operator()(const f32x4 (&acc)[2][2][4][2], const Unit& u, int wr, int wc, int fr, int fq) const {
        const int lane = fq * 16 + fr, rr = lane >> 3, cc = lane & 7;
        const int wofs = fr * 128, wx = fr & 7;
        const int rofs0 = rr * 128 + ((cc ^ (rr & 7)) << 4), rofs1 = (rr + 8) * 128 + ((cc ^ (rr & 7)) << 4);
        const int rowb = u.pm * BM + wr * 64 + rr, colb = u.pn * BM + wc * 32 + 4 * cc;
        f32x4 g2v[2];
#pragma unroll
        for (int bj = 0; bj < 2; ++bj) g2v[bj] = *(const f32x4*)(g2 + colb + bj * HALF);
#pragma unroll
        for (int q4 = 0; q4 < 4; ++q4) {
            const int ai = q4 >> 1, mb = (q4 & 1) * 2;
            f32x4 xv[2][2][2], pgv[2][2];
#pragma unroll
            for (int mm = 0; mm < 2; ++mm)
#pragma unroll
                for (int h = 0; h < 2; ++h) { const int row = rowb + ai * HALF + (mb + mm) * 16 + 8 * h;
                    pgv[mm][h] = *(const f32x4*)(ss + (size_t)row * 32 + 16 + 4 * (cc & 3));
#pragma unroll
                    for (int bj = 0; bj < 2; ++bj) xv[mm][bj][h] = *(const f32x4*)(x + (size_t)row * ldc + colb + bj * HALF); }
#pragma unroll
            for (int mm = 0; mm < 2; ++mm) { const int m = mb + mm; const int row0 = rowb + ai * HALF + m * 16;
                float rg[2], ssq[2];
#pragma unroll
                for (int h = 0; h < 2; ++h) { float sg = (pgv[mm][h][0] + pgv[mm][h][1]) + (pgv[mm][h][2] + pgv[mm][h][3]); sg += __shfl_xor(sg, 1); sg += __shfl_xor(sg, 2);
                    rg[h] = 1.0f / sqrtf(sg * (1.0f / 2048.0f) + EPS); ssq[h] = 0.f; }
#pragma unroll
                for (int bj = 0; bj < 2; ++bj) {
                    *(LAS f32x4*)(lw + wofs + (((0 + fq) ^ wx) << 4)) = acc[ai][bj][m][0];
                    *(LAS f32x4*)(lw + wofs + (((4 + fq) ^ wx) << 4)) = acc[ai][bj][m][1];
                    f32x4 av[2]; av[0] = *(const LAS f32x4*)(lw + rofs0); av[1] = *(const LAS f32x4*)(lw + rofs1);
#pragma unroll
                    for (int h = 0; h < 2; ++h) { const size_t row = (size_t)(row0 + 8 * h);
                        const f32x4 v = xv[mm][bj][h] + av[h] * rg[h];
                        ssq[h] += (v[0] * v[0] + v[1] * v[1]) + (v[2] * v[2] + v[3] * v[3]);
                        const f32x4 a = v * g2v[bj]; u32x2 w; w.x = cvt_pk_bf16(a[0], a[1]); w.y = cvt_pk_bf16(a[2], a[3]);
                        *(u32x2*)(xg + row * ldx + colb + bj * HALF) = w; }
                }
#pragma unroll
                for (int h = 0; h < 2; ++h) { float q = ssq[h]; q += __shfl_xor(q, 1); q += __shfl_xor(q, 2); q += __shfl_xor(q, 4);
                    if (cc == 0) (void)__hip_atomic_fetch_add(rss + (size_t)(row0 + 8 * h) * 16 + u.pn, q, __ATOMIC_RELAXED, __HIP_MEMORY_SCOPE_AGENT); }
            }
            asm volatile("" ::: "memory");
        }
    }
};
struct EpiHid {
    static constexpr bool PERM = true, AFTER_DRAIN = false, MID = false, COLS64 = true;
    bf16_t* H; const float* rss; int ldc; LAS unsigned char* lw;
    __device__ __forceinline__ void operator()(const f32x4 (&acc)[2][2][4][2], const Unit& u, int wr, int wc, int fr, int fq) const {
        const int lane = fq * 16 + fr, rr = lane >> 3, cc = lane & 7;
        const int row0 = u.pm * BM + wr * 64 + fr;
        bf16_t* gbase = H + (size_t)(u.pm * BM + wr * 64 + rr) * ldc + u.pn * BM + wc * 64 + 8 * cc;
        f32x4 pr[2][4];
#pragma unroll
        for (int ai = 0; ai < 2; ++ai)
#pragma unroll
            for (int m = 0; m < 4; ++m) pr[ai][m] = *(const f32x4*)(rss + (size_t)(row0 + ai * HALF + m * 16) * 16 + 4 * fq);
#pragma unroll
        for (int ai = 0; ai < 2; ++ai)
#pragma unroll
            for (int m = 0; m < 4; ++m) {
                float s = (pr[ai][m][0] + pr[ai][m][1]) + (pr[ai][m][2] + pr[ai][m][3]);
                s += __shfl_xor(s, 16); s += __shfl_xor(s, 32);
                const float r2 = 1.0f / sqrtf(s * (1.0f / 4096.0f) + EPS);
                u32x4 w[2];
#pragma unroll
                for (int bj = 0; bj < 2; ++bj) { f32x4 v0 = acc[ai][bj][m][0] * r2, v1 = acc[ai][bj][m][1] * r2;
#pragma unroll
                    for (int e = 0; e < 4; ++e) { const float a = fmaxf(v0[e], 0.f), b = fmaxf(v1[e], 0.f); v0[e] = a * a; v1[e] = b * b; }
                    w[bj].x = cvt_pk_bf16(v0[0], v0[1]); w[bj].y = cvt_pk_bf16(v0[2], v0[3]); w[bj].z = cvt_pk_bf16(v1[0], v1[1]); w[bj].w = cvt_pk_bf16(v1[2], v1[3]); }
                store_rows_bf16(lw, gbase + (size_t)(ai * HALF + m * 16) * ldc, (size_t)8 * ldc, w[0], w[1], fr, fq, rr, cc); }
    }
};
struct EpiFinal {
    static constexpr bool PERM = false, AFTER_DRAIN = false, MID = false, COLS64 = false;
    float* out; int ldc; const bf16_t* xn; int ldx; const float* g2; LAS unsigned char* lw;
    __device__ __forceinline__ void operator()(const f32x4 (&acc)[2][2][4][2], const Unit& u, int wr, int wc, int fr, int fq) const {
        const int lane = fq * 16 + fr, rr = lane >> 3, cc = lane & 7;
        const int wofs = fr * 128, wx = fr & 7;
        const int rofs0 = rr * 128 + ((cc ^ (rr & 7)) << 4), rofs1 = (rr + 8) * 128 + ((cc ^ (rr & 7)) << 4);
        const int rowb = u.pm * BM + wr * 64 + rr, colb = u.pn * BM + wc * 32 + 4 * cc;
        f32x4 ig[2];
#pragma unroll
        for (int bj = 0; bj < 2; ++bj) { const f32x4 gv = *(const f32x4*)(g2 + colb + bj * HALF); ig[bj] = (f32x4){__builtin_amdgcn_rcpf(gv[0]), __builtin_amdgcn_rcpf(gv[1]), __builtin_amdgcn_rcpf(gv[2]), __builtin_amdgcn_rcpf(gv[3])}; }
#pragma unroll
        for (int ai = 0; ai < 2; ++ai) {
            u32x2 xv[4][2][2];
#pragma unroll
            for (int m = 0; m < 4; ++m)
#pragma unroll
                for (int bj = 0; bj < 2; ++bj) { const bf16_t* g0 = xn + (size_t)(rowb + ai * HALF + m * 16) * ldx + colb + bj * HALF; xv[m][bj][0] = *(const u32x2*)g0; xv[m][bj][1] = *(const u32x2*)(g0 + (size_t)8 * ldx); }
#pragma unroll
            for (int m = 0; m < 4; ++m)
#pragma unroll
                for (int bj = 0; bj < 2; ++bj) {
                    float* g0 = out + (size_t)(rowb + ai * HALF + m * 16) * ldc + colb + bj * HALF;
                    *(LAS f32x4*)(lw + wofs + (((0 + fq) ^ wx) << 4)) = acc[ai][bj][m][0];
                    *(LAS f32x4*)(lw + wofs + (((4 + fq) ^ wx) << 4)) = acc[ai][bj][m][1];
                    const f32x4 a0 = *(const LAS f32x4*)(lw + rofs0), a1 = *(const LAS f32x4*)(lw + rofs1);
                    const u32x2 w0 = xv[m][bj][0], w1 = xv[m][bj][1];
                    const f32x4 x0 = (f32x4){bf_lo(w0.x), bf_hi(w0.x), bf_lo(w0.y), bf_hi(w0.y)} * ig[bj], x1 = (f32x4){bf_lo(w1.x), bf_hi(w1.x), bf_lo(w1.y), bf_hi(w1.y)} * ig[bj];
                    *(f32x4*)g0 = x0 + a0; *(f32x4*)(g0 + (size_t)8 * ldc) = x1 + a1;
                }
        }
    }
};

template <class Epi, class Sched, bool ALIGN_EPI = false, bool SP2 = false>
__device__ __forceinline__ void gemm_phase(LAS unsigned char* lds, const Gemm g, const Sched& S, const Epi& E) {
    const int tid = threadIdx.x, wid = __builtin_amdgcn_readfirstlane(tid >> 6), lane = tid & 63, wr = wid >> 2, wc = wid & 3, fr = lane & 15, fq = lane >> 4;
    const int K = g.K, nt = K / BK;
    unsigned voffA[2], voffB[2];
#pragma unroll
    for (int i = 0; i < 2; ++i) { int R, C; stage_rc(tid * 16 + i * 8192, R, C); const int Rq = Epi::PERM ? perm32(R & 31) : (R & 31); const int Rb = Epi::COLS64 ? (64 * (R >> 5) + Rq) : ((R & ~31) + Rq);
        voffA[i] = (unsigned)(R * g.lda + C) * 2u; voffB[i] = (unsigned)(Rb * g.ldb + C) * 2u; }
    const size_t kstep = (size_t)(BK * 2);
    const size_t hsA = (size_t)HALF * g.lda * 2, hsB = (size_t)(Epi::COLS64 ? 32 : HALF) * g.ldb * 2;
    const size_t tsA = 2 * hsA, tsB = (size_t)BM * g.ldb * 2;
    const unsigned ldsw = (unsigned)wid * 1024u;
    const int aoff = lds_byte(wr * 64 + fr, fq * 8), boff = lds_byte(wc * 32 + fr, fq * 8);
#define PG8_SA(b, h) (((b) * 2 + (h)) * HTB)
#define PG8_SB(b, h) ((4 + (b) * 2 + (h)) * HTB)
#define PG8_STAGE(bufoff, gbase, voff) do { _Pragma("unroll") for (int _i = 0; _i < 2; ++_i) \
        __builtin_amdgcn_global_load_lds((const unsigned*)((const char*)(gbase) + (voff)[_i]), (LAS unsigned*)(lds + (bufoff) + ldsw + _i * 8192), 16, 0, 0); } while (0)
#define PG8_LDA(dst, b, h) do { _Pragma("unroll") for (int m = 0; m < 4; ++m) _Pragma("unroll") for (int k = 0; k < 2; ++k) dst[m][k] = *(const LAS bf16x8*)(lds + PG8_SA(b, h) + aoff + m * 2048 + k * 1024); } while (0)
#define PG8_LDB(dst, b, h) do { _Pragma("unroll") for (int n = 0; n < 2; ++n) _Pragma("unroll") for (int k = 0; k < 2; ++k) dst[n][k] = *(const LAS bf16x8*)(lds + PG8_SB(b, h) + boff + n * 2048 + k * 1024); } while (0)
#define PG8_MMA(ai, bj, At, Bt) do { __builtin_amdgcn_s_setprio(3); _Pragma("unroll") for (int m = 0; m < 4; ++m) _Pragma("unroll") for (int n = 0; n < 2; ++n) _Pragma("unroll") for (int k = 0; k < 2; ++k) \
        acc[ai][bj][m][n] = __builtin_amdgcn_mfma_f32_16x16x32_bf16(Bt[n][k], At[m][k], acc[ai][bj][m][n], 0, 0, 0); __builtin_amdgcn_s_setprio(0); } while (0)
#define PG8_WAIT_V(n) asm volatile("s_waitcnt vmcnt(" #n ")" ::: "memory")
#define PG8_WAIT_L(n) asm volatile("s_waitcnt lgkmcnt(" #n ")" ::: "memory")
#define PG8_BAR __builtin_amdgcn_s_barrier()
#define PG8_SCHED __builtin_amdgcn_sched_barrier(0)
    Unit cur, nxt; int ui = 0;
    if (!S.next(0, cur)) return;
    f32x4 acc[2][2][4][2];
#pragma unroll
    for (int a = 0; a < 2; ++a)
#pragma unroll
        for (int b = 0; b < 2; ++b)
#pragma unroll
            for (int m = 0; m < 4; ++m)
#pragma unroll
                for (int n = 0; n < 2; ++n) acc[a][b][m][n] = (f32x4){0.f, 0.f, 0.f, 0.f};
    bf16x8 At[4][2], B0[2][2], B1[2][2];
    const char* cA = (const char*)g.A + (size_t)cur.pm * tsA; const char* cB = (const char*)g.Bt + (size_t)cur.pn * tsB;
    S.a_ready(cur);
    if constexpr (SP2) {
        PG8_STAGE(PG8_SB(0, 0), cB, voffB); PG8_STAGE(PG8_SB(0, 1), cB + hsB, voffB); PG8_STAGE(PG8_SA(0, 0), cA, voffA); PG8_STAGE(PG8_SA(0, 1), cA + hsA, voffA);
        if (wr == 1) PG8_BAR;
        PG8_WAIT_V(2); PG8_BAR;
        PG8_STAGE(PG8_SB(1, 0), cB + kstep, voffB); PG8_STAGE(PG8_SA(1, 0), cA + kstep, voffA); PG8_STAGE(PG8_SB(1, 1), cB + hsB + kstep, voffB);
        PG8_WAIT_V(6); PG8_BAR;
    } else {
        PG8_STAGE(PG8_SB(0, 0), cB, voffB); PG8_STAGE(PG8_SA(0, 0), cA, voffA); PG8_STAGE(PG8_SB(0, 1), cB + hsB, voffB); PG8_STAGE(PG8_SA(0, 1), cA + hsA, voffA);
        if (wr == 1) PG8_BAR;
        PG8_WAIT_V(4); PG8_BAR;
        PG8_STAGE(PG8_SB(1, 0), cB + kstep, voffB); PG8_STAGE(PG8_SA(1, 0), cA + kstep, voffA); PG8_STAGE(PG8_SB(1, 1), cB + hsB + kstep, voffB);
        PG8_WAIT_V(6); PG8_BAR;
    }
    for (;;) {
        const bool has_next = S.next(ui + 1, nxt);
        const char* nA = has_next ? (const char*)g.A + (size_t)nxt.pm * tsA : cA; const char* nB = has_next ? (const char*)g.Bt + (size_t)nxt.pn * tsB : cB;
        for (int t = 0; t < nt; t += 2) {
            const bool last = (t == nt - 2);
            const char* a1 = cA + (size_t)(t + 1) * kstep;
            const char* a2 = last ? nA : cA + (size_t)(t + 2) * kstep; const char* b2 = last ? nB : cB + (size_t)(t + 2) * kstep;
            const char* a3 = a2 + kstep; const char* b3 = b2 + kstep;
            if (last && has_next) S.a_ready(nxt);
            if constexpr (Epi::MID) { if (t == nt / 2) E.mid(acc, cur, wr, wc, fr, fq); }
            if constexpr (SP2) {
            PG8_LDB(B0, 0, 0); PG8_LDB(B1, 0, 1); PG8_SCHED; PG8_LDA(At, 0, 0); PG8_STAGE(PG8_SA(1, 1), a1 + hsA, voffA);
            PG8_WAIT_V(8); PG8_WAIT_L(0); PG8_BAR; PG8_MMA(0, 0, At, B0); PG8_MMA(0, 1, At, B1); PG8_BAR; PG8_SCHED;
            PG8_LDA(At, 0, 1); PG8_STAGE(PG8_SB(0, 0), b2, voffB); PG8_STAGE(PG8_SB(0, 1), b2 + hsB, voffB); PG8_STAGE(PG8_SA(0, 0), a2, voffA);
            PG8_WAIT_V(8); PG8_WAIT_L(0); PG8_BAR; PG8_MMA(1, 0, At, B0); PG8_MMA(1, 1, At, B1); PG8_BAR; PG8_SCHED;
            PG8_LDB(B0, 1, 0); PG8_LDB(B1, 1, 1); PG8_SCHED; PG8_LDA(At, 1, 0); PG8_STAGE(PG8_SA(0, 1), a2 + hsA, voffA);
            PG8_WAIT_V(8); PG8_WAIT_L(0); PG8_BAR; PG8_MMA(0, 0, At, B0); PG8_MMA(0, 1, At, B1); PG8_BAR; PG8_SCHED;
            PG8_LDA(At, 1, 1); PG8_STAGE(PG8_SB(1, 0), b3, voffB); PG8_STAGE(PG8_SB(1, 1), b3 + hsB, voffB); PG8_STAGE(PG8_SA(1, 0), a3, voffA);
            PG8_WAIT_V(8); PG8_WAIT_L(0); PG8_BAR; PG8_MMA(1, 0, At, B0); PG8_MMA(1, 1, At, B1); PG8_BAR; PG8_SCHED;
            } else {
            PG8_LDB(B0, 0, 0); PG8_SCHED; PG8_LDA(At, 0, 0); PG8_STAGE(PG8_SA(1, 1), a1 + hsA, voffA);
            PG8_WAIT_L(8); PG8_BAR; PG8_WAIT_L(0); PG8_MMA(0, 0, At, B0); PG8_BAR; PG8_SCHED;
            PG8_LDB(B1, 0, 1); PG8_STAGE(PG8_SB(0, 0), b2, voffB);
            PG8_BAR; PG8_WAIT_L(0); PG8_MMA(0, 1, At, B1); PG8_BAR;
            PG8_LDA(At, 0, 1); PG8_STAGE(PG8_SA(0, 0), a2, voffA);
            PG8_BAR; PG8_WAIT_L(0); PG8_MMA(1, 0, At, B0); PG8_BAR; PG8_SCHED;
            PG8_STAGE(PG8_SB(0, 1), b2 + hsB, voffB);
            PG8_WAIT_V(6); PG8_BAR; PG8_MMA(1, 1, At, B1); PG8_BAR;
            PG8_LDB(B0, 1, 0); PG8_SCHED; PG8_LDA(At, 1, 0); PG8_STAGE(PG8_SA(0, 1), a2 + hsA, voffA);
            PG8_WAIT_L(8); PG8_BAR; PG8_WAIT_L(0); PG8_MMA(0, 0, At, B0); PG8_BAR; PG8_SCHED;
            PG8_LDB(B1, 1, 1); PG8_STAGE(PG8_SB(1, 0), b3, voffB);
            PG8_BAR; PG8_WAIT_L(0); PG8_MMA(0, 1, At, B1); PG8_BAR;
            PG8_LDA(At, 1, 1); PG8_STAGE(PG8_SA(1, 0), a3, voffA);
            PG8_BAR; PG8_WAIT_L(0); PG8_MMA(1, 0, At, B0); PG8_BAR; PG8_SCHED;
            PG8_STAGE(PG8_SB(1, 1), b3 + hsB, voffB);
            PG8_WAIT_V(6); PG8_BAR; PG8_MMA(1, 1, At, B1); PG8_BAR;
            }
        }
        if constexpr (ALIGN_EPI) { if (wr == 0) PG8_BAR; }
        if constexpr (!Epi::AFTER_DRAIN) { E(acc, cur, wr, wc, fr, fq); S.done(cur); }
        if (!has_next) break;
#pragma unroll
        for (int a = 0; a < 2; ++a)
#pragma unroll
            for (int b = 0; b < 2; ++b)
#pragma unroll
                for (int m = 0; m < 4; ++m)
#pragma unroll
                    for (int n = 0; n < 2; ++n) acc[a][b][m][n] = (f32x4){0.f, 0.f, 0.f, 0.f};
        cur = nxt; cA = nA; cB = nB; ++ui;
        if constexpr (ALIGN_EPI) { if (wr == 1) PG8_BAR; }
    }
    PG8_WAIT_V(0);
    if constexpr (!ALIGN_EPI) { if (wr == 0) PG8_BAR; }
    PG8_BAR;
#undef PG8_SA
#undef PG8_SB
#undef PG8_STAGE
#undef PG8_LDA
#undef PG8_LDB
#undef PG8_MMA
#undef PG8_WAIT_V
#undef PG8_WAIT_L
#undef PG8_BAR
#undef PG8_SCHED
}
}

constexpr int NWAVES = 8;
constexpr int BATCH = 4, SEQ = 4096, D = 4096, M = BATCH * SEQ;
constexpr int INW = 7168, MIXW = 4096, FF = 16384;
constexpr int O_K = 2048, O_V = 2560, O_U = 3072, O_G = 5120;
constexpr int NBLK = SEQ / 128;
constexpr float EPS = 1e-6f;
constexpr size_t MiB = 1u << 20;
constexpr int LDK4 = D + 64, LDK16 = FF + 64;
constexpr size_t WS_BIAS = 1 * MiB;
constexpr size_t WS_SS = 2 * MiB;
constexpr size_t WS_RSS = 4 * MiB;
constexpr size_t WS_VSS = 8 * MiB;
constexpr size_t WS_WIN = 10 * MiB;
constexpr size_t WS_WOUT = 68 * MiB;
constexpr size_t WS_W1 = 101 * MiB;
constexpr size_t WS_W2 = 231 * MiB;
constexpr size_t WS_XN = 360 * MiB;
constexpr size_t WS_HID = 490 * MiB;
constexpr size_t WS_Z = 490 * MiB;
constexpr size_t WS_AG = 714 * MiB;
constexpr size_t WS_END = 1004 * MiB;
static_assert(WS_WIN + (size_t)INW * LDK4 * 2 <= WS_WOUT && WS_WOUT + (size_t)D * LDK4 * 2 <= WS_W1 && WS_W1 + (size_t)FF * LDK4 * 2 <= WS_W2 && WS_W2 + (size_t)D * LDK16 * 2 <= WS_XN, "ws map (weights)");
static_assert(WS_XN + (size_t)M * LDK4 * 2 <= WS_HID && WS_HID + (size_t)M * LDK16 * 2 <= WS_END && WS_Z + (size_t)M * INW * 2 <= WS_AG && WS_AG + (size_t)M * MIXW * 2 <= WS_END, "ws map (activations)");
constexpr int LDS_BYTES = 147456;

#define LDS_WAIT() asm volatile("s_waitcnt lgkmcnt(0)" ::: "memory")
__device__ __forceinline__ float wave_sum(float v) {
#pragma unroll
    for (int o = 1; o < 64; o <<= 1) v += __shfl_xor(v, o);
    return v;
}
__device__ __forceinline__ void p0_row_load(const float* __restrict__ xr, f32x4 (&v)[16], int lane) {
#pragma unroll
    for (int j = 0; j < 8; ++j) { v[2 * j] = __builtin_nontemporal_load((const f32x4*)(xr + 512 * j + 8 * lane)); v[2 * j + 1] = __builtin_nontemporal_load((const f32x4*)(xr + 512 * j + 8 * lane + 4)); }
}
__device__ __forceinline__ void p0_row_store(const f32x4 (&v)[16], const float* __restrict__ g, bf16_t* __restrict__ o, int lane) {
    float s = 0.f;
#pragma unroll
    for (int j = 0; j < 16; ++j) s += (v[j][0] * v[j][0] + v[j][1] * v[j][1]) + (v[j][2] * v[j][2] + v[j][3] * v[j][3]);
    const float r = 1.0f / sqrtf(wave_sum(s) * (1.0f / D) + EPS);
#pragma unroll
    for (int j = 0; j < 8; ++j) { const f32x4 g0 = *(const f32x4*)(g + 512 * j + 8 * lane), g1 = *(const f32x4*)(g + 512 * j + 8 * lane + 4);
        const f32x4 a = v[2 * j] * r * g0, b = v[2 * j + 1] * r * g1;
        u32x4 w; w.x = cvt_pk_bf16(a[0], a[1]); w.y = cvt_pk_bf16(a[2], a[3]); w.z = cvt_pk_bf16(b[0], b[1]); w.w = cvt_pk_bf16(b[2], b[3]);
        *(u32x4*)(o + 512 * j + 8 * lane) = w; }
}
__device__ __forceinline__ int t5_bucket_dev(int rel) {
    const int n = rel < 0 ? -rel : rel;
    const int large = 8 + (n >= 12) + (n >= 16) + (n >= 23) + (n >= 32) + (n >= 46) + (n >= 64) + (n >= 91);
    return (rel > 0 ? 16 : 0) + (n < 8 ? n : large);
}

namespace mixp {
constexpr int KSTR = 272;
constexpr int K_OFF = 0, V_OFF = 128 * KSTR, B_OFF = V_OFF + 32768, MIX_LDS = B_OFF + 1056;
__device__ __forceinline__ unsigned offb(unsigned row, unsigned ch) { return 256u * row + 16u * (ch ^ (((row & 3u) << 2) | ((row >> 2) & 3u))); }
__device__ __forceinline__ bf16x8 tr_frag(LAS unsigned char* vimg, int rbase, int c, int lane) {
    const unsigned fq = lane >> 4, q = (lane & 15) >> 2, p = lane & 3;
    const unsigned r0 = rbase + 4 * fq + q, r1 = r0 + 16;
    const s16x4 t0 = __builtin_amdgcn_ds_read_tr16_b64_v4i16((LAS s16x4*)(vimg + offb(r0, 2 * c + (p >> 1)) + 8 * (p & 1)));
    const s16x4 t1 = __builtin_amdgcn_ds_read_tr16_b64_v4i16((LAS s16x4*)(vimg + offb(r1, 2 * c + (p >> 1)) + 8 * (p & 1)));
    return __builtin_shufflevector(t0, t1, 0, 1, 2, 3, 4, 5, 6, 7);
}
__device__ __forceinline__ float sumsq8(u32x4 w) {
    const float a0 = bf_lo(w.x), a1 = bf_hi(w.x), a2 = bf_lo(w.y), a3 = bf_hi(w.y), a4 = bf_lo(w.z), a5 = bf_hi(w.z), a6 = bf_lo(w.w), a7 = bf_hi(w.w);
    return (a0 * a0 + a1 * a1) + (a2 * a2 + a3 * a3) + (a4 * a4 + a5 * a5) + (a6 * a6 + a7 * a7);
}
__device__ __forceinline__ u32x4 scale8(u32x4 w, float r, const float* __restrict__ g) {
    const f32x4 g0 = *(const f32x4*)g, g1 = *(const f32x4*)(g + 4);
    u32x4 o; o.x = cvt_pk_bf16(bf_lo(w.x) * r * g0[0], bf_hi(w.x) * r * g0[1]); o.y = cvt_pk_bf16(bf_lo(w.y) * r * g0[2], bf_hi(w.y) * r * g0[3]);
    o.z = cvt_pk_bf16(bf_lo(w.z) * r * g1[0], bf_hi(w.z) * r * g1[1]); o.w = cvt_pk_bf16(bf_lo(w.w) * r * g1[2], bf_hi(w.w) * r * g1[3]); return o;
}

struct MixArgs { const bf16_t* Z; const float* biasT; const float* qg; const float* kg; const float* sink; const float* vgain; const float* ws; const float* bs; bf16_t* AG; float* SS; const float* VSS; };

struct ConvJob { const float* w1; const float* w2; bf16_t* w1t; bf16_t* w2t; int next, stride; };
constexpr int CONV_BLOCKS = 2 * 32768;
__device__ __forceinline__ void conv_load(const ConvJob& J, int idx, f32x4 (&v)[8], int lane) {
    const bool second = idx >= 32768; const int r = idx & 32767;
    const float* W = second ? J.w2 : J.w1; const int N = second ? D : FF, nb = second ? 128 : 512;
    const int k0 = 64 * (r / nb), n0 = 32 * (r % nb);
    const float* p = W + (size_t)(k0 + 8 * (lane >> 3)) * N + n0 + 4 * (lane & 7);
#pragma unroll
    for (int i = 0; i < 8; ++i) v[i] = __builtin_nontemporal_load((const f32x4*)(p + (size_t)i * N));
}
__device__ __forceinline__ void conv_store(const ConvJob& J, int idx, const f32x4 (&v)[8], int lane) {
    const bool second = idx >= 32768; const int r = idx & 32767;
    bf16_t* WT = second ? J.w2t : J.w1t; const int ldt = second ? LDK16 : LDK4, nb = second ? 128 : 512;
    const int k0 = 64 * (r / nb), n0 = 32 * (r % nb);
    bf16_t* q = WT + (size_t)(n0 + 4 * (lane & 7)) * ldt + k0 + 8 * (lane >> 3);
#pragma unroll
    for (int j = 0; j < 4; ++j) { u32x4 o; o.x = cvt_pk_bf16(v[0][j], v[1][j]); o.y = cvt_pk_bf16(v[2][j], v[3][j]); o.z = cvt_pk_bf16(v[4][j], v[5][j]); o.w = cvt_pk_bf16(v[6][j], v[7][j]);
        __builtin_nontemporal_store(o, (u32x4*)(q + (size_t)j * ldt)); }
}
#define MIX_LDS_BARRIER() do { asm volatile("s_waitcnt lgkmcnt(0)" ::: "memory"); __builtin_amdgcn_s_barrier(); asm volatile("" ::: "memory"); } while (0)
constexpr int KV_BUF = V_OFF + 32768;
constexpr int BT_OFF = 2 * KV_BUF;
constexpr int RN_OFF = BT_OFF + 2048;
static_assert(RN_OFF + 1024 <= 147456, "mixer LDS map");

__device__ __forceinline__ void attn_stream(LAS unsigned char* lds, const MixArgs& A, ConvJob& J, int vcu, int G, int tid, int wid, int lane) {
    constexpr int NU = BATCH * NBLK * 16;
    constexpr float L2E = 1.4426950408889634f;
    const int fr = lane & 15, fq = lane >> 4, skey = tid >> 2, spart = tid & 3, arow = 16 * wid + fr;
    LAS float* bt = (LAS float*)(lds + BT_OFF);
    if (vcu >= NU) return;
    int u = vcu, h = u & 15, bb = u >> 4, b = bb / NBLK, blk = bb % NBLK;
    int kb = (blk == 0) ? 1 : 0, khi = (blk == NBLK - 1) ? 1 : 2;
    int bt_head = -1;
    u32x4 kr[4], vr[4], qraw[4];
#define ATT_LOADKV(b_, blk_, kb_, h_) do { const bf16_t* kp_ = A.Z + ((size_t)(b_) * SEQ + (size_t)((blk_) - 1 + (kb_)) * 128 + skey) * INW + O_K + ((h_) >> 2) * 128 + 8 * spart; \
        _Pragma("unroll") for (int i = 0; i < 4; ++i) { kr[i] = *(const u32x4*)(kp_ + 32 * i); vr[i] = *(const u32x4*)(kp_ + (O_V - O_K) + 32 * i); } } while (0)
#define ATT_LOADQ(b_, blk_, h_) do { const bf16_t* qp_ = A.Z + ((size_t)(b_) * SEQ + (size_t)(blk_) * 128 + arow) * INW + (h_) * 128 + 8 * fq; \
        _Pragma("unroll") for (int s = 0; s < 4; ++s) qraw[s] = *(const u32x4*)(qp_ + 32 * s); } while (0)
#define ATT_WRITEKV(buf_) do { float ss_ = 0.f; _Pragma("unroll") for (int i = 0; i < 4; ++i) ss_ += sumsq8(kr[i]); \
        ss_ += __shfl_xor(ss_, 1); ss_ += __shfl_xor(ss_, 2); \
        if (spart == 0) ((LAS float*)(lds + RN_OFF))[(buf_) * 128 + skey] = 1.0f / sqrtf(ss_ * (1.0f / 128.0f) + EPS); \
        _Pragma("unroll") for (int i = 0; i < 4; ++i) { *(LAS u32x4*)(lds + (buf_) * KV_BUF + K_OFF + skey * KSTR + (4 * i + spart) * 16) = kr[i]; \
            *(LAS u32x4*)(lds + (buf_) * KV_BUF + V_OFF + offb(skey, 4 * i + spart)) = vr[i]; } } while (0)
    ATT_LOADKV(b, blk, kb, h); ATT_LOADQ(b, blk, h);
    __syncthreads();
    ATT_WRITEKV(0);
    int buf = 0; bool first = true;
    bf16x8 qf[4]; float mrun = 0.f, lpart = 0.f, sinkv = 0.f; f32x4 oacc[8];
    for (;;) {
        if (first) {
            if (h != bt_head) { __syncthreads(); if (tid < 511) { const int idx = tid - 127; bt[tid] = (idx >= 0 && idx <= 256) ? A.biasT[h * 260 + idx] : -1e30f; } bt_head = h; }
            float ss = 0.f;
#pragma unroll
            for (int s = 0; s < 4; ++s) ss += sumsq8(qraw[s]);
            ss += __shfl_xor(ss, 16); ss += __shfl_xor(ss, 32);
            const float rn = (1.0f / sqrtf(ss * (1.0f / 128.0f) + EPS)) * 0.08838834764831845f;
#pragma unroll
            for (int s = 0; s < 4; ++s) {
                const f32x4 g0 = *(const f32x4*)(A.qg + 32 * s + 8 * fq) * *(const f32x4*)(A.kg + 32 * s + 8 * fq), g1 = *(const f32x4*)(A.qg + 32 * s + 8 * fq + 4) * *(const f32x4*)(A.kg + 32 * s + 8 * fq + 4);
                const u32x4 w = qraw[s]; u32x4 o;
                o.x = cvt_pk_bf16(bf_lo(w.x) * rn * g0[0], bf_hi(w.x) * rn * g0[1]); o.y = cvt_pk_bf16(bf_lo(w.y) * rn * g0[2], bf_hi(w.y) * rn * g0[3]);
                o.z = cvt_pk_bf16(bf_lo(w.z) * rn * g1[0], bf_hi(w.z) * rn * g1[1]); o.w = cvt_pk_bf16(bf_lo(w.w) * rn * g1[2], bf_hi(w.w) * rn * g1[3]);
                qf[s] = __builtin_bit_cast(bf16x8, o); }
            sinkv = A.sink[h]; mrun = sinkv; lpart = 0.f;
#pragma unroll
            for (int c = 0; c < 8; ++c) oacc[c] = (f32x4){0.f, 0.f, 0.f, 0.f};
        }
        MIX_LDS_BARRIER();
        int nkb = kb + 1, nu = u, nh = h, nb_ = b, nblk = blk, nkhi = khi; bool nfirst = false, nvalid = true;
        if (nkb > khi) { nu = u + G; nfirst = true;
            if (nu < NU) { nh = nu & 15; const int nbb = nu >> 4; nb_ = nbb / NBLK; nblk = nbb % NBLK; nkb = (nblk == 0) ? 1 : 0; nkhi = (nblk == NBLK - 1) ? 1 : 2; } else nvalid = false; }
        const bool last = (kb == khi);
        if (nvalid) ATT_LOADKV(nb_, nblk, nkb, nh);
        f32x4 cv[8]; const int cidx = J.next; const bool cdo = cidx < CONV_BLOCKS;
        if (cdo) conv_load(J, cidx, cv, lane);
        LAS unsigned char* kbase = lds + buf * KV_BUF + K_OFF; LAS unsigned char* vbase = lds + buf * KV_BUF + V_OFF;
        f32x4 sacc[8];
#pragma unroll
        for (int kt = 0; kt < 8; ++kt) { sacc[kt] = (f32x4){0.f, 0.f, 0.f, 0.f};
#pragma unroll
            for (int s = 0; s < 4; ++s) { const bf16x8 a = *(const LAS bf16x8*)(kbase + (16 * kt + fr) * KSTR + (32 * s + 8 * fq) * 2);
                sacc[kt] = __builtin_amdgcn_mfma_f32_16x16x32_bf16(a, qf[s], sacc[kt], 0, 0, 0); } }
        float bm = -1e30f;
        {
            const LAS float* btp = bt + (kb * 128 + 4 * fq - arow + 127);
            const LAS f32x4* rnp = (const LAS f32x4*)(lds + RN_OFF) + buf * 32 + fq;
#pragma unroll
            for (int kt = 0; kt < 8; ++kt) { const f32x4 rk = rnp[4 * kt];
#pragma unroll
                for (int j = 0; j < 4; ++j) { const float v = sacc[kt][j] * rk[j] + btp[16 * kt + j]; sacc[kt][j] = v; bm = fmaxf(bm, v); } }
        }
        bm = fmaxf(bm, __shfl_xor(bm, 16)); bm = fmaxf(bm, __shfl_xor(bm, 32));
        const float mnew = fmaxf(mrun, bm), alpha = __builtin_amdgcn_exp2f((mrun - mnew) * L2E);
        mrun = mnew; lpart *= alpha;
#pragma unroll
        for (int c = 0; c < 8; ++c) oacc[c] = oacc[c] * alpha;
        const float moff = mnew * L2E;
        bf16x8 pf[4];
#pragma unroll
        for (int ks = 0; ks < 4; ++ks) { float p[8];
#pragma unroll
            for (int j = 0; j < 4; ++j) { p[j] = __builtin_amdgcn_exp2f(sacc[2 * ks][j] * L2E - moff); p[4 + j] = __builtin_amdgcn_exp2f(sacc[2 * ks + 1][j] * L2E - moff); }
            lpart += ((p[0] + p[1]) + (p[2] + p[3])) + ((p[4] + p[5]) + (p[6] + p[7]));
            u32x4 w; w.x = cvt_pk_bf16(p[0], p[1]); w.y = cvt_pk_bf16(p[2], p[3]); w.z = cvt_pk_bf16(p[4], p[5]); w.w = cvt_pk_bf16(p[6], p[7]);
            pf[ks] = __builtin_bit_cast(bf16x8, w); }
#pragma unroll
        for (int ks = 0; ks < 4; ++ks)
#pragma unroll
            for (int c = 0; c < 8; ++c) { const bf16x8 a = tr_frag(vbase, 32 * ks, c, lane);
                oacc[c] = __builtin_amdgcn_mfma_f32_16x16x32_bf16(a, pf[ks], oacc[c], 0, 0, 0); }
        if (last) {
            float l = lpart; l += __shfl_xor(l, 16); l += __shfl_xor(l, 32);
            l += __builtin_amdgcn_exp2f((sinkv - mrun) * L2E);
            const float inv = 1.0f / l;
            const size_t tok = (size_t)b * SEQ + (size_t)blk * 128 + arow;
            bf16_t* op = A.AG + tok * MIXW + h * 128 + 4 * fq;
            float ssq = 0.f;
#pragma unroll
            for (int c = 0; c < 8; ++c) { const f32x4 o = oacc[c] * inv; ssq += (o[0] * o[0] + o[1] * o[1]) + (o[2] * o[2] + o[3] * o[3]);
                u32x2 w; w.x = cvt_pk_bf16(o[0], o[1]); w.y = cvt_pk_bf16(o[2], o[3]); *(u32x2*)(op + 16 * c) = w; }
            ssq += __shfl_xor(ssq, 16); ssq += __shfl_xor(ssq, 32);
            if (fq == 0) A.SS[tok * 32 + h] = ssq;
        }
        if (nvalid) {
            if (nfirst) ATT_LOADQ(nb_, nblk, nh);
            ATT_WRITEKV(buf ^ 1);
        }
        if (cdo) { conv_store(J, cidx, cv, lane); J.next = cidx + J.stride; }
        if (!nvalid) break;
        buf ^= 1; kb = nkb; u = nu; h = nh; b = nb_; blk = nblk; khi = nkhi; first = nfirst;
    }
#undef ATT_LOADKV
#undef ATT_LOADQ
#undef ATT_WRITEKV
}

__device__ __forceinline__ void gmlp_stream(LAS unsigned char* lds, const MixArgs& A, ConvJob& J, int vcu, int G, int tid, int wid, int lane) {
    constexpr int NU = BATCH * NBLK * 16;
    const int fr = lane & 15, fq = lane >> 4, skey = tid >> 2, spart = tid & 3, trow = 16 * wid + fr;
    if (vcu >= NU) return;
    int u = vcu, hh = u & 15, bb = u >> 4;
    u32x4 vr[4]; f32x4 pa, pb;
#define GM_LOADV(bb_, hh_) do { const size_t t_ = (size_t)(bb_) * 128 + skey; const bf16_t* vp_ = A.Z + t_ * INW + O_G + (hh_) * 128 + 8 * spart; \
        _Pragma("unroll") for (int i = 0; i < 4; ++i) vr[i] = *(const u32x4*)(vp_ + 32 * i); \
        pa = *(const f32x4*)(A.VSS + t_ * 32 + 8 * spart); pb = *(const f32x4*)(A.VSS + t_ * 32 + 8 * spart + 4); } while (0)
#define GM_WRITEV(buf_, hh_) do { float ss_ = ((pa[0] + pa[1]) + (pa[2] + pa[3])) + ((pb[0] + pb[1]) + (pb[2] + pb[3])); \
        ss_ += __shfl_xor(ss_, 1); ss_ += __shfl_xor(ss_, 2); const float rn_ = 1.0f / sqrtf(ss_ * (1.0f / 2048.0f) + EPS); \
        _Pragma("unroll") for (int i = 0; i < 4; ++i) *(LAS u32x4*)(lds + (buf_) * KV_BUF + V_OFF + offb(skey, 4 * i + spart)) = scale8(vr[i], rn_, A.vgain + (hh_) * 128 + 32 * i + 8 * spart); } while (0)
    GM_LOADV(bb, hh);
    __syncthreads();
    GM_WRITEV(0, hh);
    int buf = 0, w_head = -1; bf16x8 wf[4]; float bsv = 0.f;
    for (;;) {
        if (hh != w_head) {
            const float* wp = A.ws + ((size_t)hh * 128 + trow) * 128 + 4 * fq;
#pragma unroll
            for (int ks = 0; ks < 4; ++ks) { const f32x4 a = *(const f32x4*)(wp + 32 * ks), c = *(const f32x4*)(wp + 32 * ks + 16);
                u32x4 w; w.x = cvt_pk_bf16(a[0], a[1]); w.y = cvt_pk_bf16(a[2], a[3]); w.z = cvt_pk_bf16(c[0], c[1]); w.w = cvt_pk_bf16(c[2], c[3]);
                wf[ks] = __builtin_bit_cast(bf16x8, w); }
            bsv = A.bs[hh * 128 + trow]; w_head = hh;
        }
        MIX_LDS_BARRIER();
        const int nu = u + G; const bool nvalid = nu < NU; const int nhh = nu & 15, nbb = nu >> 4;
        if (nvalid) GM_LOADV(nbb, nhh);
        f32x4 cv[8]; const int cidx = J.next; const bool cdo = cidx < CONV_BLOCKS;
        if (cdo) conv_load(J, cidx, cv, lane);
        const size_t tok = (size_t)bb * 128 + trow;
        const bf16_t* up = A.Z + tok * INW + O_U + hh * 128 + 4 * fq;
        u32x2 uu[8];
#pragma unroll
        for (int c = 0; c < 8; ++c) uu[c] = *(const u32x2*)(up + 16 * c);
        LAS unsigned char* vbase = lds + buf * KV_BUF + V_OFF;
        f32x4 acc[8];
#pragma unroll
        for (int c = 0; c < 8; ++c) acc[c] = (f32x4){0.f, 0.f, 0.f, 0.f};
#pragma unroll
        for (int ks = 0; ks < 4; ++ks)
#pragma unroll
            for (int c = 0; c < 8; ++c) { const bf16x8 a = tr_frag(vbase, 32 * ks, c, lane);
                acc[c] = __builtin_amdgcn_mfma_f32_16x16x32_bf16(a, wf[ks], acc[c], 0, 0, 0); }
        bf16_t* op = A.AG + tok * MIXW + 2048 + hh * 128 + 4 * fq;
        float ssq = 0.f;
#pragma unroll
        for (int c = 0; c < 8; ++c) {
            f32x4 o; o[0] = bf_lo(uu[c].x) * (acc[c][0] + bsv); o[1] = bf_hi(uu[c].x) * (acc[c][1] + bsv); o[2] = bf_lo(uu[c].y) * (acc[c][2] + bsv); o[3] = bf_hi(uu[c].y) * (acc[c][3] + bsv);
            ssq += (o[0] * o[0] + o[1] * o[1]) + (o[2] * o[2] + o[3] * o[3]);
            u32x2 w; w.x = cvt_pk_bf16(o[0], o[1]); w.y = cvt_pk_bf16(o[2], o[3]); *(u32x2*)(op + 16 * c) = w; }
        ssq += __shfl_xor(ssq, 16); ssq += __shfl_xor(ssq, 32);
        if (fq == 0) A.SS[tok * 32 + 16 + hh] = ssq;
        if (nvalid) GM_WRITEV(buf ^ 1, nhh);
        if (cdo) { conv_store(J, cidx, cv, lane); J.next = cidx + J.stride; }
        if (!nvalid) break;
        buf ^= 1; u = nu; hh = nhh; bb = nbb;
    }
#undef GM_LOADV
#undef GM_WRITEV
}
}

struct Args {
    const float *x, *norm1, *w_in, *q_gain, *k_gain, *rel_bias, *attn_sink, *attn_out_gain, *gmlp_v_gain, *gmlp_w_s, *gmlp_b_s, *gmlp_out_gain, *w_out, *norm2, *w1, *w2;
    float* out; unsigned char* ws; int ph_lo, ph_hi;
};
constexpr int N_PHASES = 7;

__global__ void __launch_bounds__(NWAVES * 64, 2) fwd_mega(Args args) {
    extern __shared__ __attribute__((aligned(16))) unsigned char lds_raw[];
    LAS unsigned char* lds = (LAS unsigned char*)lds_raw;
    const int tid = threadIdx.x, lane = tid & 63, wave = __builtin_amdgcn_readfirstlane(tid >> 6);
    const int G = gridDim.x, bx = blockIdx.x;
    const int vcu = (G % 8 == 0) ? (bx % 8) * (G / 8) + bx / 8 : bx;
    unsigned char* ws = args.ws;
    bf16_t* Win_t = (bf16_t*)(ws + WS_WIN); bf16_t* Wout_t = (bf16_t*)(ws + WS_WOUT); bf16_t* W1_t = (bf16_t*)(ws + WS_W1); bf16_t* W2_t = (bf16_t*)(ws + WS_W2);
    bf16_t* XN = (bf16_t*)(ws + WS_XN); bf16_t* Z = (bf16_t*)(ws + WS_Z); bf16_t* AG = (bf16_t*)(ws + WS_AG); bf16_t* HID = (bf16_t*)(ws + WS_HID);
    float* biasT = (float*)(ws + WS_BIAS); float* SS = (float*)(ws + WS_SS); float* RSS = (float*)(ws + WS_RSS); float* VSS = (float*)(ws + WS_VSS);
    const int lo = args.ph_lo, hi = args.ph_hi;
#define IN(k) (lo <= (k) && (k) < hi)
#define SEAM(k) do { if (IN(k) && IN((k) + 1)) cg::this_grid().sync(); } while (0)

    if (IN(0)) {
        const int gw = vcu * NWAVES + wave, NGW = G * NWAVES;
        constexpr int B_IN = (D / 64) * (INW / 32), B_OUT = (MIXW / 64) * (D / 32), NBLK0 = B_IN + B_OUT;
        auto blk_load = [&](int it, f32x4 (&v)[8]) {
            const bool second = it >= B_IN; const int r = second ? it - B_IN : it;
            const float* W = second ? args.w_out : args.w_in; const int N = second ? D : INW, nb = N / 32;
            const float* p = W + (size_t)(64 * (r / nb) + 8 * (lane >> 3)) * N + 32 * (r % nb) + 4 * (lane & 7);
#pragma unroll
            for (int i = 0; i < 8; ++i) v[i] = __builtin_nontemporal_load((const f32x4*)(p + (size_t)i * N));
        };
        auto blk_store = [&](int it, f32x4 (&v)[8]) {
            const bool second = it >= B_IN; const int r = second ? it - B_IN : it;
            bf16_t* WT = second ? Wout_t : Win_t; const int nb = (second ? D : INW) / 32;
            const int k0 = 64 * (r / nb) + 8 * (lane >> 3), n0 = 32 * (r % nb) + 4 * (lane & 7);
            if (second) {
                const float* gp = (k0 < 2048) ? args.attn_out_gain + k0 : args.gmlp_out_gain + (k0 - 2048);
                const f32x4 g0 = *(const f32x4*)gp, g1 = *(const f32x4*)(gp + 4);
#pragma unroll
                for (int i = 0; i < 4; ++i) { v[i] = v[i] * g0[i]; v[4 + i] = v[4 + i] * g1[i]; }
            }
            bf16_t* q = WT + (size_t)n0 * LDK4 + k0;
#pragma unroll
            for (int j = 0; j < 4; ++j) { u32x4 o; o.x = cvt_pk_bf16(v[0][j], v[1][j]); o.y = cvt_pk_bf16(v[2][j], v[3][j]); o.z = cvt_pk_bf16(v[4][j], v[5][j]); o.w = cvt_pk_bf16(v[6][j], v[7][j]);
                *(u32x4*)(q + (size_t)j * LDK4) = o; }
        };
        {
            f32x4 va[8], vb[8]; int it = gw;
            if (it < NBLK0) blk_load(it, va);
            while (it < NBLK0) {
                const int n1 = it + NGW; if (n1 < NBLK0) blk_load(n1, vb);
                blk_store(it, va);
                if (n1 >= NBLK0) break;
                const int n2 = n1 + NGW; if (n2 < NBLK0) blk_load(n2, va);
                blk_store(n1, vb);
                it = n2;
            }
        }
        {
            f32x4 va[16], vb[16]; int m = gw;
            if (m < M) p0_row_load(args.x + (size_t)m * D, va, lane);
            while (m < M) {
                const int m1 = m + NGW; if (m1 < M) p0_row_load(args.x + (size_t)m1 * D, vb, lane);
                p0_row_store(va, args.norm1, XN + (size_t)m * LDK4, lane);
                if (m1 >= M) break;
                const int m2 = m1 + NGW; if (m2 < M) p0_row_load(args.x + (size_t)m2 * D, va, lane);
                p0_row_store(vb, args.norm1, XN + (size_t)m1 * LDK4, lane);
                m = m2;
            }
        }
        for (int e = (vcu * NWAVES * 64 + tid) * 4; e < M * 16; e += G * NWAVES * 64 * 4) *(f32x4*)(RSS + e) = (f32x4){0.f, 0.f, 0.f, 0.f};
        if (bx == 0) for (int e = tid; e < 16 * 257; e += NWAVES * 64) { const int h = e / 257, idx = e % 257; biasT[h * 260 + idx] = args.rel_bias[t5_bucket_dev(idx - 128) * 16 + h]; }
    }
    SEAM(0);
    if (IN(1)) {
        pg8::Gemm g{XN, Win_t, M, INW, D, LDK4, LDK4}; pg8::StaticOrder S; S.init(M, INW, G, bx);
        pg8::EpiZ E{Z, INW, O_U, VSS, O_G, lds + pg8::STAGE_BYTES + wave * 2048};
        pg8::gemm_phase<pg8::EpiZ, pg8::StaticOrder, true, true>(lds, g, S, E);
    }
    SEAM(1);
    if (IN(2)) {
        const mixp::MixArgs A{Z, biasT, args.q_gain, args.k_gain, args.attn_sink, args.gmlp_v_gain, args.gmlp_w_s, args.gmlp_b_s, AG, SS, VSS};
        mixp::ConvJob J{args.w1, args.w2, W1_t, W2_t, vcu * NWAVES + wave, G * NWAVES};
        mixp::attn_stream(lds, A, J, vcu, G, tid, wave, lane);
        mixp::gmlp_stream(lds, A, J, vcu, G, tid, wave, lane);
        while (J.next < mixp::CONV_BLOCKS) { f32x4 cv[8]; mixp::conv_load(J, J.next, cv, lane); mixp::conv_store(J, J.next, cv, lane); J.next += J.stride; }
    }
    SEAM(2);
    if (IN(4)) {
        pg8::Gemm g{AG, Wout_t, M, D, MIXW, MIXW, LDK4}; pg8::StaticOrder S; S.init(M, D, G, bx);
        pg8::EpiOut E{args.x, args.out, XN, args.norm2, RSS, SS, D, LDK4, lds + pg8::STAGE_BYTES + wave * 2048};
        pg8::gemm_phase<pg8::EpiOut, pg8::StaticOrder, true, true>(lds, g, S, E);
    }
    SEAM(4);
    if (IN(5)) {
        pg8::Gemm g{XN, W1_t, M, FF, D, LDK4, LDK4}; pg8::StaticOrder S; S.init(M, FF, G, bx);
        pg8::EpiHid E{HID, RSS, LDK16, lds + pg8::STAGE_BYTES + wave * 2048};
        pg8::gemm_phase<pg8::EpiHid, pg8::StaticOrder, true, true>(lds, g, S, E);
    }
    SEAM(5);
    if (IN(6)) {
        pg8::Gemm g{HID, W2_t, M, D, FF, LDK16, LDK16}; pg8::StaticOrder S; S.init(M, D, G, bx);
        pg8::EpiFinal E{args.out, D, XN, LDK4, args.norm2, lds + pg8::STAGE_BYTES + wave * 2048};
        pg8::gemm_phase<pg8::EpiFinal, pg8::StaticOrder, true, true>(lds, g, S, E);
    }
#undef IN
#undef SEAM
}

extern "C" void kernel_launch(void* const* d_in, const int* in_sizes, int n_in, void* d_out, int out_size, void* d_ws, size_t ws_size, hipStream_t stream) {
    static int grid = 0;
    if (grid == 0) {
        if (n_in != 16 || in_sizes[0] != M * D || out_size != M * D || ws_size < WS_END) { fprintf(stderr, "kernel_launch: unexpected shapes (n_in %d, in0 %d, out %d, ws %zu); nothing launched\n", n_in, n_in > 0 ? in_sizes[0] : -1, out_size, ws_size); grid = -1; return; }
        int dev = 0, cus = 0, per_cu = 0;
        if (hipGetDevice(&dev) != hipSuccess || hipDeviceGetAttribute(&cus, hipDeviceAttributeMultiprocessorCount, dev) != hipSuccess) { grid = -1; return; }
        if (hipFuncSetAttribute((const void*)fwd_mega, hipFuncAttributeMaxDynamicSharedMemorySize, LDS_BYTES) != hipSuccess) { fprintf(stderr, "kernel_launch: hipFuncSetAttribute failed\n"); grid = -1; return; }
        if (hipOccupancyMaxActiveBlocksPerMultiprocessor(&per_cu, (const void*)fwd_mega, NWAVES * 64, LDS_BYTES) != hipSuccess || per_cu < 1) { fprintf(stderr, "kernel_launch: occupancy query says %d blocks/CU\n", per_cu); per_cu = 1; }
        (void)hipGetLastError();
        grid = cus;
    }
    if (grid < 0) return;
    Args a{};
    a.x = (const float*)d_in[0]; a.norm1 = (const float*)d_in[1]; a.w_in = (const float*)d_in[2]; a.q_gain = (const float*)d_in[3]; a.k_gain = (const float*)d_in[4];
    a.rel_bias = (const float*)d_in[5]; a.attn_sink = (const float*)d_in[6]; a.attn_out_gain = (const float*)d_in[7]; a.gmlp_v_gain = (const float*)d_in[8];
    a.gmlp_w_s = (const float*)d_in[9]; a.gmlp_b_s = (const float*)d_in[10]; a.gmlp_out_gain = (const float*)d_in[11]; a.w_out = (const float*)d_in[12];
    a.norm2 = (const float*)d_in[13]; a.w1 = (const float*)d_in[14]; a.w2 = (const float*)d_in[15];
    a.out = (float*)d_out; a.ws = (unsigned char*)d_ws;
#if MK_N_LAUNCHES == 1
    a.ph_lo = 0; a.ph_hi = N_PHASES;
    void* kargs[] = {&a};
    hipError_t e = hipLaunchCooperativeKernel((const void*)fwd_mega, dim3(grid), dim3(NWAVES * 64), kargs, LDS_BYTES, stream);
    if (e != hipSuccess) fprintf(stderr, "kernel_launch: cooperative launch failed: %s (grid %d)\n", hipGetErrorString(e), grid);
#else
    for (int ph = 0; ph < N_PHASES; ++ph) {
        a.ph_lo = ph; a.ph_hi = ph + 1;
        hipLaunchKernelGGL(fwd_mega, dim3(grid), dim3(NWAVES * 64), LDS_BYTES, stream, a);
    }
#endif
}
```

```cpp
#include <hip/hip_runtime.h>
#include <hip/hip_cooperative_groups.h>
#include <cstdio>
#include <cstdint>
namespace cg = cooperative_groups;

#ifndef MK_N_LAUNCHES
#define MK_N_LAUNCHES 1
#endif

#define LAS __attribute__((address_space(3)))
typedef unsigned short bf16_t;
typedef short bf16x8 __attribute__((ext_vector_type(8)));
typedef short s16x4 __attribute__((ext_vector_type(4)));
typedef float f32x4 __attribute__((ext_vector_type(4)));
typedef unsigned u32x4 __attribute__((ext_vector_type(4)));
typedef unsigned u32x2 __attribute__((ext_vector_type(2)));

__device__ __forceinline__ unsigned cvt_pk_bf16(float lo, float hi) { unsigned r; asm volatile("v_cvt_pk_bf16_f32 %0, %1, %2" : "=v"(r) : "v"(lo), "v"(hi)); return r; }
__device__ __forceinline__ float bf_lo(unsigned w) { return __uint_as_float(w << 16); }
__device__ __forceinline__ float bf_hi(unsigned w) { return __uint_as_float(w & 0xffff0000u); }
__device__ __forceinline__ float gelu_tanh(float x) {
    const float u = x * (0.7978845608028654f + 0.035677408136300125f * x * x);
    const float e = __builtin_amdgcn_exp2f(-2.885390081777927f * u);
    return x * __builtin_amdgcn_rcpf(1.0f + e);
}

namespace pg8 {
constexpr int BM = 256, BK = 64, HALF = 128, HTB = HALF * BK * 2, STAGE_BYTES = 8 * HTB, NXCD = 8, WGM = 4;
__host__ __device__ __forceinline__ int lds_byte(int r, int c) { const int st = (r >> 4) * 2 + (c >> 5), rr = r & 15, cc = c & 31, ob = rr * 64 + cc * 2; return st * 1024 + (ob ^ (((ob >> 9) & 1) << 5)); }
__host__ __device__ __forceinline__ void stage_rc(int b, int& R, int& C) { const int st = b / 1024, sb = b % 1024, swz = sb ^ (((sb >> 9) & 1) << 5); R = (st >> 1) * 16 + swz / 64; C = (st & 1) * 32 + (swz % 64) / 2; }
__host__ __device__ __forceinline__ int perm32(int rho) { const int n = rho >> 4, i = rho & 15; return 8 * (i >> 2) + 4 * n + (i & 3); }

struct Unit { int pm, pn; };
struct Gemm { const bf16_t* A; const bf16_t* Bt; int M, N, K, lda, ldb; };

struct StaticOrder {
    int nM, nN, nwg, G, c;
    __host__ __device__ void init(int M, int N, int G_, int c_) { nM = M / BM; nN = N / BM; nwg = nM * nN; G = G_; c = c_; }
    __host__ __device__ bool next(int i, Unit& u) const {
        const long L = (long)i * G + c; if (L >= nwg) return false;
        int wgid = (int)L; { const int q = nwg / NXCD, r = nwg % NXCD, xcd = wgid % NXCD, off = wgid / NXCD; wgid = (xcd < r ? xcd * (q + 1) : r * (q + 1) + (xcd - r) * q) + off; }
        const int nig = WGM * nN, gid = wgid / nig, fm = gid * WGM, gsz = (nM - fm) < WGM ? (nM - fm) : WGM;
        u.pm = fm + ((wgid % nig) % gsz); u.pn = (wgid % nig) / gsz; return true;
    }
    __device__ __forceinline__ void a_ready(const Unit&) const {}
    __device__ __forceinline__ void done(const Unit&) const {}
};

constexpr float EPS = 1e-6f;

__device__ __forceinline__ void store_rows_bf16(LAS unsigned char* lw, bf16_t* gp  , size_t ld8  , const u32x4& w0, const u32x4& w1, int fr, int fq, int rr, int cc) {
    *(LAS u32x4*)(lw + fr * 128 + (((0 + fq) ^ (fr & 7)) << 4)) = w0;
    *(LAS u32x4*)(lw + fr * 128 + (((4 + fq) ^ (fr & 7)) << 4)) = w1;
    const u32x4 a0 = *(const LAS u32x4*)(lw + rr * 128 + ((cc ^ (rr & 7)) << 4)), a1 = *(const LAS u32x4*)(lw + (rr + 8) * 128 + ((cc ^ (rr & 7)) << 4));
    *(u32x4*)gp = a0; *(u32x4*)(gp + ld8) = a1;
}
struct EpiZ {
    static constexpr bool PERM = true, AFTER_DRAIN = false, MID = false, COLS64 = true;
    bf16_t* O; int ldc; int gelu_from; float* vss; int vss_from; LAS unsigned char* lw;
    __device__ __forceinline__ void operator()(const f32x4 (&acc)[2][2][4][2], const Unit& u, int wr, int wc, int fr, int fq) const {
        const int lane = fq * 16 + fr, rr = lane >> 3, cc = lane & 7;
        const int row0 = u.pm * BM + wr * 64 + fr;
        bf16_t* gbase = O + (size_t)(u.pm * BM + wr * 64 + rr) * ldc + u.pn * BM + wc * 64 + 8 * cc;
        const bool act = (u.pn * BM >= gelu_from), vs = (u.pn * BM >= vss_from);
#pragma unroll
        for (int ai = 0; ai < 2; ++ai)
#pragma unroll
            for (int m = 0; m < 4; ++m) { const int row = row0 + ai * HALF + m * 16; float ssq = 0.f; u32x4 w[2];
#pragma unroll
                for (int bj = 0; bj < 2; ++bj) { f32x4 v0 = acc[ai][bj][m][0], v1 = acc[ai][bj][m][1];
                    if (act) { v0 = (f32x4){gelu_tanh(v0[0]), gelu_tanh(v0[1]), gelu_tanh(v0[2]), gelu_tanh(v0[3])}; v1 = (f32x4){gelu_tanh(v1[0]), gelu_tanh(v1[1]), gelu_tanh(v1[2]), gelu_tanh(v1[3])}; }
                    ssq += (v0[0] * v0[0] + v0[1] * v0[1]) + (v0[2] * v0[2] + v0[3] * v0[3]) + (v1[0] * v1[0] + v1[1] * v1[1]) + (v1[2] * v1[2] + v1[3] * v1[3]);
                    w[bj].x = cvt_pk_bf16(v0[0], v0[1]); w[bj].y = cvt_pk_bf16(v0[2], v0[3]); w[bj].z = cvt_pk_bf16(v1[0], v1[1]); w[bj].w = cvt_pk_bf16(v1[2], v1[3]); }
                store_rows_bf16(lw, gbase + (size_t)(ai * HALF + m * 16) * ldc, (size_t)8 * ldc, w[0], w[1], fr, fq, rr, cc);
                if (vs) { ssq += __shfl_xor(ssq, 16); ssq += __shfl_xor(ssq, 32); if (fq == 0) vss[(size_t)row * 32 + (u.pn - vss_from / BM) * 4 + wc] = ssq; } }
    }
};
struct EpiOut {
    static constexpr bool PERM = false, AFTER_DRAIN = false, MID = true, COLS64 = false;
    const float* x; float* out; bf16_t* xg; const float* g2; float* rss; const float* ss; int ldc, ldx; LAS unsigned char* lw;
    __device__ __forceinline__ void mid(f32x4 (&acc)[2][2][4][2], const Unit& u, int wr, int wc, int fr_, int fq_) const {
        int fr = fr_, fq = fq_; asm volatile("" : "+v"(fr), "+v"(fq));
        const int row0 = u.pm * BM + wr * 64 + fr;
#pragma unroll
        for (int ai = 0; ai < 2; ++ai)
#pragma unroll
            for (int m = 0; m < 4; ++m) { const int row = row0 + ai * HALF + m * 16;
                const f32x4 pa = *(const f32x4*)(ss + (size_t)row * 32 + 4 * fq), pg = *(const f32x4*)(ss + (size_t)row * 32 + 16 + 4 * fq);
                float sa = (pa[0] + pa[1]) + (pa[2] + pa[3]), sg = (pg[0] + pg[1]) + (pg[2] + pg[3]);
                sa += __shfl_xor(sa, 16); sa += __shfl_xor(sa, 32); sg += __shfl_xor(sg, 16); sg += __shfl_xor(sg, 32);
                const float f = sqrtf((sg * (1.0f / 2048.0f) + EPS) / (sa * (1.0f / 2048.0f) + EPS));
#pragma unroll
                for (int bj = 0; bj < 2; ++bj) { acc[ai][bj][m][0] = acc[ai][bj][m][0] * f; acc[ai][bj][m][1] = acc[ai][bj][m][1] * f; } }
    }
    __device__ __forceinline__ void operator()(const f32x4 (&acc)[2][2][4][2], const Unit& u, int wr, int wc, int fr, int fq) const {
        const int lane = fq * 16 + fr, rr = lane >> 3, cc = lane & 7;
        const int wofs = fr * 128, wx = fr & 7;
        const int rofs0 = rr * 128 + ((cc ^ (rr & 7)) << 4), rofs1 = (rr + 8) * 128 + ((cc ^ (rr & 7)) << 4);
        const int rowb = u.pm * BM + wr * 64 + rr, colb = u.pn * BM + wc * 32 + 4 * cc;
        f32x4 g2v[2];
#pragma unroll
        for (int bj = 0; bj < 2; ++bj) g2v[bj] = *(const f32x4*)(g2 + colb + bj * HALF);
#pragma unroll
        for (int q4 = 0; q4 < 4; ++q4) {
            const int ai = q4 >> 1, mb = (q4 & 1) * 2;
            f32x4 xv[2][2][2], pgv[2][2];
#pragma unroll
            for (int mm = 0; mm < 2; ++mm)
#pragma unroll
                for (int h = 0; h < 2; ++h) { const int row = rowb + ai * HALF + (mb + mm) * 16 + 8 * h;
                    pgv[mm][h] = *(const f32x4*)(ss + (size_t)row * 32 + 16 + 4 * (cc & 3));
#pragma unroll
                    for (int bj = 0; bj < 2; ++bj) xv[mm][bj][h] = *(const f32x4*)(x + (size_t)row * ldc + colb + bj * HALF); }
#pragma unroll
            for (int mm = 0; mm < 2; ++mm) { const int m = mb + mm; const int row0 = rowb + ai * HALF + m * 16;
                float rg[2], ssq[2];
#pragma unroll
                for (int h = 0; h < 2; ++h) { float sg = (pgv[mm][h][0] + pgv[mm][h][1]) + (pgv[mm][h][2] + pgv[mm][h][3]); sg += __shfl_xor(sg, 1); sg += __shfl_xor(sg, 2);
                    rg[h] = 1.0f / sqrtf(sg * (1.0f / 2048.0f) + EPS); ssq[h] = 0.f; }
#pragma unroll
                for (int bj = 0; bj < 2; ++bj) {
                    *(LAS f32x4*)(lw + wofs + (((0 + fq) ^ wx) << 4)) = acc[ai][bj][m][0];
                    *(LAS f32x4*)(lw + wofs + (((4 + fq) ^ wx) << 4)) = acc[ai][bj][m][1];
                    f32x4 av[2]; av[0] = *(const LAS f32x4*)(lw + rofs0); av[1] = *(const LAS f32x4*)(lw + rofs1);
#pragma unroll
                    for (int h = 0; h < 2; ++h) { const size_t row = (size_t)(row0 + 8 * h);
                        const f32x4 v = xv[mm][bj][h] + av[h] * rg[h];
                        ssq[h] += (v[0] * v[0] + v[1] * v[1]) + (v[2] * v[2] + v[3] * v[3]);
                        const f32x4 a = v * g2v[bj]; u32x2 w; w.x = cvt_pk_bf16(a[0], a[1]); w.y = cvt_pk_bf16(a[2], a[3]);
                        *(u32x2*)(xg + row * ldx + colb + bj * HALF) = w; }
                }
#pragma unroll
                for (int h = 0; h < 2; ++h) { float q = ssq[h]; q += __shfl_xor(q, 1); q += __shfl_xor(q, 2); q += __shfl_xor(q, 4);
                    if (cc == 0) (void)__hip_atomic_fetch_add(rss + (size_t)(row0 + 8 * h) * 16 + u.pn, q, __ATOMIC_RELAXED, __HIP_MEMORY_SCOPE_AGENT); }
            }
            asm volatile("" ::: "memory");
        }
    }
};
struct EpiHid {
    static constexpr bool PERM = true, AFTER_DRAIN = false, MID = false, COLS64 = true;
    bf16_t* H; const float* rss; int ldc; LAS unsigned char* lw;
    __device__ __forceinline__ void operator()(const f32x4 (&acc)[2][2][4][2], const Unit& u, int wr, int wc, int fr, int fq) const {
        const int lane = fq * 16 + fr, rr = lane >> 3, cc = lane & 7;
        const int row0 = u.pm * BM + wr * 64 + fr;
        bf16_t* gbase = H + (size_t)(u.pm * BM + wr * 64 + rr) * ldc + u.pn * BM + wc * 64 + 8 * cc;
        f32x4 pr[2][4];
#pragma unroll
        for (int ai = 0; ai < 2; ++ai)
#pragma unroll
            for (int m = 0; m < 4; ++m) pr[ai][m] = *(const f32x4*)(rss + (size_t)(row0 + ai * HALF + m * 16) * 16 + 4 * fq);
#pragma unroll
        for (int ai = 0; ai < 2; ++ai)
#pragma unroll
            for (int m = 0; m < 4; ++m) {
                float s = (pr[ai][m][0] + pr[ai][m][1]) + (pr[ai][m][2] + pr[ai][m][3]);
                s += __shfl_xor(s, 16); s += __shfl_xor(s, 32);
                const float r2 = 1.0f / sqrtf(s * (1.0f / 4096.0f) + EPS);
                u32x4 w[2];
#pragma unroll
                for (int bj = 0; bj < 2; ++bj) { f32x4 v0 = acc[ai][bj][m][0] * r2, v1 = acc[ai][bj][m][1] * r2;
#pragma unroll
                    for (int e = 0; e < 4; ++e) { const float a = fmaxf(v0[e], 0.f), b = fmaxf(v1[e], 0.f); v0[e] = a * a; v1[e] = b * b; }
                    w[bj].x = cvt_pk_bf16(v0[0], v0[1]); w[bj].y = cvt_pk_bf16(v0[2], v0[3]); w[bj].z = cvt_pk_bf16(v1[0], v1[1]); w[bj].w = cvt_pk_bf16(v1[2], v1[3]); }
                store_rows_bf16(lw, gbase + (size_t)(ai * HALF + m * 16) * ldc, (size_t)8 * ldc, w[0], w[1], fr, fq, rr, cc); }
    }
};
struct EpiFinal {
    static constexpr bool PERM = false, AFTER_DRAIN = false, MID = false, COLS64 = false;
    float* out; int ldc; const bf16_t* xn; int ldx; const float* g2; LAS unsigned char* lw;
    __device__ __forceinline__ void operator()(const f32x4 (&acc)[2][2][4][2], const Unit& u, int wr, int wc, int fr, int fq) const {
        const int lane = fq * 16 + fr, rr = lane >> 3, cc = lane & 7;
        const int wofs = fr * 128, wx = fr & 7;
        const int rofs0 = rr * 128 + ((cc ^ (rr & 7)) << 4), rofs1 = (rr + 8) * 128 + ((cc ^ (rr & 7)) << 4);
        const int rowb = u.pm * BM + wr * 64 + rr, colb = u.pn * BM + wc * 32 + 4 * cc;
        f32x4 ig[2];
#pragma unroll
        for (int bj = 0; bj < 2; ++bj) { const f32x4 gv = *(const f32x4*)(g2 + colb + bj * HALF); ig[bj] = (f32x4){__builtin_amdgcn_rcpf(gv[0]), __builtin_amdgcn_rcpf(gv[1]), __builtin_amdgcn_rcpf(gv[2]), __builtin_amdgcn_rcpf(gv[3])}; }
#pragma unroll
        for (int ai = 0; ai < 2; ++ai) {
            u32x2 xv[4][2][2];
#pragma unroll
            for (int m = 0; m < 4; ++m)
#pragma unroll
                for (int bj = 0; bj < 2; ++bj) { const bf16_t* g0 = xn + (size_t)(rowb + ai * HALF + m * 16) * ldx + colb + bj * HALF; xv[m][bj][0] = *(const u32x2*)g0; xv[m][bj][1] = *(const u32x2*)(g0 + (size_t)8 * ldx); }
#pragma unroll
            for (int m = 0; m < 4; ++m)
#pragma unroll
                for (int bj = 0; bj < 2; ++bj) {
                    float* g0 = out + (size_t)(rowb + ai * HALF + m * 16) * ldc + colb + bj * HALF;
                    *(LAS f32x4*)(lw + wofs + (((0 + fq) ^ wx) << 4)) = acc[ai][bj][m][0];
                    *(LAS f32x4*)(lw + wofs + (((4 + fq) ^ wx) << 4)) = acc[ai][bj][m][1];
                    const f32x4 a0 = *(const LAS f32x4*)(lw + rofs0), a1 = *(const LAS f32x4*)(lw + rofs1);
                    const u32x2 w0 = xv[m][bj][0], w1 = xv[m][bj][1];
                    const f32x4 x0 = (f32x4){bf_lo(w0.x), bf_hi(w0.x), bf_lo(w0.y), bf_hi(w0.y)} * ig[bj], x1 = (f32x4){bf_lo(w1.x), bf_hi(w1.x), bf_lo(w1.y), bf_hi(w1.y)} * ig[bj];
                    *(f32x4*)g0 = x0 + a0; *(f32x4*)(g0 + (size_t)8 * ldc) = x1 + a1;
                }
        }
    }
};

template <class Epi, class Sched, bool ALIGN_EPI = false, bool SP2 = false>
__device__ __forceinline__ void gemm_phase(LAS unsigned char* lds, const Gemm g, const Sched& S, const Epi& E) {
    const int tid = threadIdx.x, wid = __builtin_amdgcn_readfirstlane(tid >> 6), lane = tid & 63, wr = wid >> 2, wc = wid & 3, fr = lane & 15, fq = lane >> 4;
    const int K = g.K, nt = K / BK;
    unsigned voffA[2], voffB[2];
#pragma unroll
    for (int i = 0; i < 2; ++i) { int R, C; stage_rc(tid * 16 + i * 8192, R, C); const int Rq = Epi::PERM ? perm32(R & 31) : (R & 31); const int Rb = Epi::COLS64 ? (64 * (R >> 5) + Rq) : ((R & ~31) + Rq);
        voffA[i] = (unsigned)(R * g.lda + C) * 2u; voffB[i] = (unsigned)(Rb * g.ldb + C) * 2u; }
    const size_t kstep = (size_t)(BK * 2);
    const size_t hsA = (size_t)HALF * g.lda * 2, hsB = (size_t)(Epi::COLS64 ? 32 : HALF) * g.ldb * 2;
    const size_t tsA = 2 * hsA, tsB = (size_t)BM * g.ldb * 2;
    const unsigned ldsw = (unsigned)wid * 1024u;
    const int aoff = lds_byte(wr * 64 + fr, fq * 8), boff = lds_byte(wc * 32 + fr, fq * 8);
#define PG8_SA(b, h) (((b) * 2 + (h)) * HTB)
#define PG8_SB(b, h) ((4 + (b) * 2 + (h)) * HTB)
#define PG8_STAGE(bufoff, gbase, voff) do { _Pragma("unroll") for (int _i = 0; _i < 2; ++_i) \
        __builtin_amdgcn_global_load_lds((const unsigned*)((const char*)(gbase) + (voff)[_i]), (LAS unsigned*)(lds + (bufoff) + ldsw + _i * 8192), 16, 0, 0); } while (0)
#define PG8_LDA(dst, b, h) do { _Pragma("unroll") for (int m = 0; m < 4; ++m) _Pragma("unroll") for (int k = 0; k < 2; ++k) dst[m][k] = *(const LAS bf16x8*)(lds + PG8_SA(b, h) + aoff + m * 2048 + k * 1024); } while (0)
#define PG8_LDB(dst, b, h) do { _Pragma("unroll") for (int n = 0; n < 2; ++n) _Pragma("unroll") for (int k = 0; k < 2; ++k) dst[n][k] = *(const LAS bf16x8*)(lds + PG8_SB(b, h) + boff + n * 2048 + k * 1024); } while (0)
#define PG8_MMA(ai, bj, At, Bt) do { __builtin_amdgcn_s_setprio(3); _Pragma("unroll") for (int m = 0; m < 4; ++m) _Pragma("unroll") for (int n = 0; n < 2; ++n) _Pragma("unroll") for (int k = 0; k < 2; ++k) \
        acc[ai][bj][m][n] = __builtin_amdgcn_mfma_f32_16x16x32_bf16(Bt[n][k], At[m][k], acc[ai][bj][m][n], 0, 0, 0); __builtin_amdgcn_s_setprio(0); } while (0)
#define PG8_WAIT_V(n) asm volatile("s_waitcnt vmcnt(" #n ")" ::: "memory")
#define PG8_WAIT_L(n) asm volatile("s_waitcnt lgkmcnt(" #n ")" ::: "memory")
#define PG8_BAR __builtin_amdgcn_s_barrier()
#define PG8_SCHED __builtin_amdgcn_sched_barrier(0)
    Unit cur, nxt; int ui = 0;
    if (!S.next(0, cur)) return;
    f32x4 acc[2][2][4][2];
#pragma unroll
    for (int a = 0; a < 2; ++a)
#pragma unroll
        for (int b = 0; b < 2; ++b)
#pragma unroll
            for (int m = 0; m < 4; ++m)
#pragma unroll
                for (int n = 0; n < 2; ++n) acc[a][b][m][n] = (f32x4){0.f, 0.f, 0.f, 0.f};
    bf16x8 At[4][2], B0[2][2], B1[2][2];
    const char* cA = (const char*)g.A + (size_t)cur.pm * tsA; const char* cB = (const char*)g.Bt + (size_t)cur.pn * tsB;
    S.a_ready(cur);
    if constexpr (SP2) {
        PG8_STAGE(PG8_SB(0, 0), cB, voffB); PG8_STAGE(PG8_SB(0, 1), cB + hsB, voffB); PG8_STAGE(PG8_SA(0, 0), cA, voffA); PG8_STAGE(PG8_SA(0, 1), cA + hsA, voffA);
        if (wr == 1) PG8_BAR;
        PG8_WAIT_V(2); PG8_BAR;
        PG8_STAGE(PG8_SB(1, 0), cB + kstep, voffB); PG8_STAGE(PG8_SA(1, 0), cA + kstep, voffA); PG8_STAGE(PG8_SB(1, 1), cB + hsB + kstep, voffB);
        PG8_WAIT_V(6); PG8_BAR;
    } else {
        PG8_STAGE(PG8_SB(0, 0), cB, voffB); PG8_STAGE(PG8_SA(0, 0), cA, voffA); PG8_STAGE(PG8_SB(0, 1), cB + hsB, voffB); PG8_STAGE(PG8_SA(0, 1), cA + hsA, voffA);
        if (wr == 1) PG8_BAR;
        PG8_WAIT_V(4); PG8_BAR;
        PG8_STAGE(PG8_SB(1, 0), cB + kstep, voffB); PG8_STAGE(PG8_SA(1, 0), cA + kstep, voffA); PG8_STAGE(PG8_SB(1, 1), cB + hsB + kstep, voffB);
        PG8_WAIT_V(6); PG8_BAR;
    }
    for (;;) {
        const bool has_next = S.next(ui + 1, nxt);
        const char* nA = has_next ? (const char*)g.A + (size_t)nxt.pm * tsA : cA; const char* nB = has_next ? (const char*)g.Bt + (size_t)nxt.pn * tsB : cB;
        for (int t = 0; t < nt; t += 2) {
            const bool last = (t == nt - 2);
            const char* a1 = cA + (size_t)(t + 1) * kstep;
            const char* a2 = last ? nA : cA + (size_t)(t + 2) * kstep; const char* b2 = last ? nB : cB + (size_t)(t + 2) * kstep;
            const char* a3 = a2 + kstep; const char* b3 = b2 + kstep;
            if (last && has_next) S.a_ready(nxt);
            if constexpr (Epi::MID) { if (t == nt / 2) E.mid(acc, cur, wr, wc, fr, fq); }
            if constexpr (SP2) {
            PG8_LDB(B0, 0, 0); PG8_LDB(B1, 0, 1); PG8_SCHED; PG8_LDA(At, 0, 0); PG8_STAGE(PG8_SA(1, 1), a1 + hsA, voffA);
            PG8_WAIT_V(8); PG8_WAIT_L(0); PG8_BAR; PG8_MMA(0, 0, At, B0); PG8_MMA(0, 1, At, B1); PG8_BAR; PG8_SCHED;
            PG8_LDA(At, 0, 1); PG8_STAGE(PG8_SB(0, 0), b2, voffB); PG8_STAGE(PG8_SB(0, 1), b2 + hsB, voffB); PG8_STAGE(PG8_SA(0, 0), a2, voffA);
            PG8_WAIT_V(8); PG8_WAIT_L(0); PG8_BAR; PG8_MMA(1, 0, At, B0); PG8_MMA(1, 1, At, B1); PG8_BAR; PG8_SCHED;
            PG8_LDB(B0, 1, 0); PG8_LDB(B1, 1, 1); PG8_SCHED; PG8_LDA(At, 1, 0); PG8_STAGE(PG8_SA(0, 1), a2 + hsA, voffA);
            PG8_WAIT_V(8); PG8_WAIT_L(0); PG8_BAR; PG8_MMA(0, 0, At, B0); PG8_MMA(0, 1, At, B1); PG8_BAR; PG8_SCHED;
            PG8_LDA(At, 1, 1); PG8_STAGE(PG8_SB(1, 0), b3, voffB); PG8_STAGE(PG8_SB(1, 1), b3 + hsB, voffB); PG8_STAGE(PG8_SA(1, 0), a3, voffA);
            PG8_WAIT_V(8); PG8_WAIT_L(0); PG8_BAR; PG8_MMA(1, 0, At, B0); PG8_MMA(1, 1, At, B1); PG8_BAR; PG8_SCHED;
            } else {
            PG8_LDB(B0, 0, 0); PG8_SCHED; PG8_LDA(At, 0, 0); PG8_STAGE(PG8_SA(1, 1), a1 + hsA, voffA);
            PG8_WAIT_L(8); PG8_BAR; PG8_WAIT_L(0); PG8_MMA(0, 0, At, B0); PG8_BAR; PG8_SCHED;
            PG8_LDB(B1, 0, 1); PG8_STAGE(PG8_SB(0, 0), b2, voffB);
            PG8_BAR; PG8_WAIT_L(0); PG8_MMA(0, 1, At, B1); PG8_BAR;
            PG8_LDA(At, 0, 1); PG8_STAGE(PG8_SA(0, 0), a2, voffA);
            PG8_BAR; PG8_WAIT_L(0); PG8_MMA(1, 0, At, B0); PG8_BAR; PG8_SCHED;
            PG8_STAGE(PG8_SB(0, 1), b2 + hsB, voffB);
            PG8_WAIT_V(6); PG8_BAR; PG8_MMA(1, 1, At, B1); PG8_BAR;
            PG8_LDB(B0, 1, 0); PG8_SCHED; PG8_LDA(At, 1, 0); PG8_STAGE(PG8_SA(0, 1), a2 + hsA, voffA);
            PG8_WAIT_L(8); PG8_BAR; PG8_WAIT_L(0); PG8_MMA(0, 0, At, B0); PG8_BAR; PG8_SCHED;
            PG8_LDB(B1, 1, 1); PG8_STAGE(PG8_SB(1, 0), b3, voffB);
            PG8_BAR; PG8_WAIT_L(0); PG8_MMA(0, 1, At, B1); PG8_BAR;
            PG8_LDA(At, 1, 1); PG8_STAGE(PG8_SA(1, 0), a3, voffA);
            PG8_BAR; PG8_WAIT_L(0); PG8_MMA(1, 0, At, B0); PG8_BAR; PG8_SCHED;
            PG8_STAGE(PG8_SB(1, 1), b3 + hsB, voffB);
            PG8_WAIT_V(6); PG8_BAR; PG8_MMA(1, 1, At, B1); PG8_BAR;
            }
        }
        if constexpr (ALIGN_EPI) { if (wr == 0) PG8_BAR; }
        if constexpr (!Epi::AFTER_DRAIN) { E(acc, cur, wr, wc, fr, fq); S.done(cur); }
        if (!has_next) break;
#pragma unroll
        for (int a = 0; a < 2; ++a)
#pragma unroll
            for (int b = 0; b < 2; ++b)
#pragma unroll
                for (int m = 0; m < 4; ++m)
#pragma unroll
                    for (int n = 0; n < 2; ++n) acc[a][b][m][n] = (f32x4){0.f, 0.f, 0.f, 0.f};
        cur = nxt; cA = nA; cB = nB; ++ui;
        if constexpr (ALIGN_EPI) { if (wr == 1) PG8_BAR; }
    }
    PG8_WAIT_V(0);
    if constexpr (!ALIGN_EPI) { if (wr == 0) PG8_BAR; }
    PG8_BAR;
#undef PG8_SA
#undef PG8_SB
#undef PG8_STAGE
#undef PG8_LDA
#undef PG8_LDB
#undef PG8_MMA
#undef PG8_WAIT_V
#undef PG8_WAIT_L
#undef PG8_BAR
#undef PG8_SCHED
}
}

constexpr int NWAVES = 8;
constexpr int BATCH = 4, SEQ = 4096, D = 4096, M = BATCH * SEQ;
constexpr int INW = 7168, MIXW = 4096, FF = 16384;
constexpr int O_K = 2048, O_V = 2560, O_U = 3072, O_G = 5120;
constexpr int NBLK = SEQ / 128;
constexpr float EPS = 1e-6f;
constexpr size_t MiB = 1u << 20;
constexpr int LDK4 = D + 64, LDK16 = FF + 64;
constexpr size_t WS_BIAS = 1 * MiB;
constexpr size_t WS_SS = 2 * MiB;
constexpr size_t WS_RSS = 4 * MiB;
constexpr size_t WS_VSS = 8 * MiB;
constexpr size_t WS_WIN = 10 * MiB;
constexpr size_t WS_WOUT = 68 * MiB;
constexpr size_t WS_W1 = 101 * MiB;
constexpr size_t WS_W2 = 231 * MiB;
constexpr size_t WS_XN = 360 * MiB;
constexpr size_t WS_HID = 490 * MiB;
constexpr size_t WS_Z = 490 * MiB;
constexpr size_t WS_AG = 714 * MiB;
constexpr size_t WS_END = 1004 * MiB;
static_assert(WS_WIN + (size_t)INW * LDK4 * 2 <= WS_WOUT && WS_WOUT + (size_t)D * LDK4 * 2 <= WS_W1 && WS_W1 + (size_t)FF * LDK4 * 2 <= WS_W2 && WS_W2 + (size_t)D * LDK16 * 2 <= WS_XN, "ws map (weights)");
static_assert(WS_XN + (size_t)M * LDK4 * 2 <= WS_HID && WS_HID + (size_t)M * LDK16 * 2 <= WS_END && WS_Z + (size_t)M * INW * 2 <= WS_AG && WS_AG + (size_t)M * MIXW * 2 <= WS_END, "ws map (activations)");
constexpr int LDS_BYTES = 147456;

#define LDS_WAIT() asm volatile("s_waitcnt lgkmcnt(0)" ::: "memory")
__device__ __forceinline__ float wave_sum(float v) {
#pragma unroll
    for (int o = 1; o < 64; o <<= 1) v += __shfl_xor(v, o);
    return v;
}
__device__ __forceinline__ void p0_row_load(const float* __restrict__ xr, f32x4 (&v)[16], int lane) {
#pragma unroll
    for (int j = 0; j < 8; ++j) { v[2 * j] = __builtin_nontemporal_load((const f32x4*)(xr + 512 * j + 8 * lane)); v[2 * j + 1] = __builtin_nontemporal_load((const f32x4*)(xr + 512 * j + 8 * lane + 4)); }
}
__device__ __forceinline__ void p0_row_store(const f32x4 (&v)[16], const float* __restrict__ g, bf16_t* __restrict__ o, int lane) {
    float s = 0.f;
#pragma unroll
    for (int j = 0; j < 16; ++j) s += (v[j][0] * v[j][0] + v[j][1] * v[j][1]) + (v[j][2] * v[j][2] + v[j][3] * v[j][3]);
    const float r = 1.0f / sqrtf(wave_sum(s) * (1.0f / D) + EPS);
#pragma unroll
    for (int j = 0; j < 8; ++j) { const f32x4 g0 = *(const f32x4*)(g + 512 * j + 8 * lane), g1 = *(const f32x4*)(g + 512 * j + 8 * lane + 4);
        const f32x4 a = v[2 * j] * r * g0, b = v[2 * j + 1] * r * g1;
        u32x4 w; w.x = cvt_pk_bf16(a[0], a[1]); w.y = cvt_pk_bf16(a[2], a[3]); w.z = cvt_pk_bf16(b[0], b[1]); w.w = cvt_pk_bf16(b[2], b[3]);
        *(u32x4*)(o + 512 * j + 8 * lane) = w; }
}
__device__ __forceinline__ int t5_bucket_dev(int rel) {
    const int n = rel < 0 ? -rel : rel;
    const int large = 8 + (n >= 12) + (n >= 16) + (n >= 23) + (n >= 32) + (n >= 46) + (n >= 64) + (n >= 91);
    return (rel > 0 ? 16 : 0) + (n < 8 ? n : large);
}

namespace mixp {
constexpr int KSTR = 272;
constexpr int K_OFF = 0, V_OFF = 128 * KSTR, B_OFF = V_OFF + 32768, MIX_LDS = B_OFF + 1056;
__device__ __forceinline__ unsigned offb(unsigned row, unsigned ch) { return 256u * row + 16u * (ch ^ (((row & 3u) << 2) | ((row >> 2) & 3u))); }
__device__ __forceinline__ bf16x8 tr_frag(LAS unsigned char* vimg, int rbase, int c, int lane) {
    const unsigned fq = lane >> 4, q = (lane & 15) >> 2, p = lane & 3;
    const unsigned r0 = rbase + 4 * fq + q, r1 = r0 + 16;
    const s16x4 t0 = __builtin_amdgcn_ds_read_tr16_b64_v4i16((LAS s16x4*)(vimg + offb(r0, 2 * c + (p >> 1)) + 8 * (p & 1)));
    const s16x4 t1 = __builtin_amdgcn_ds_read_tr16_b64_v4i16((LAS s16x4*)(vimg + offb(r1, 2 * c + (p >> 1)) + 8 * (p & 1)));
    return __builtin_shufflevector(t0, t1, 0, 1, 2, 3, 4, 5, 6, 7);
}
__device__ __forceinline__ float sumsq8(u32x4 w) {
    const float a0 = bf_lo(w.x), a1 = bf_hi(w.x), a2 = bf_lo(w.y), a3 = bf_hi(w.y), a4 = bf_lo(w.z), a5 = bf_hi(w.z), a6 = bf_lo(w.w), a7 = bf_hi(w.w);
    return (a0 * a0 + a1 * a1) + (a2 * a2 + a3 * a3) + (a4 * a4 + a5 * a5) + (a6 * a6 + a7 * a7);
}
__device__ __forceinline__ u32x4 scale8(u32x4 w, float r, const float* __restrict__ g) {
    const f32x4 g0 = *(const f32x4*)g, g1 = *(const f32x4*)(g + 4);
    u32x4 o; o.x = cvt_pk_bf16(bf_lo(w.x) * r * g0[0], bf_hi(w.x) * r * g0[1]); o.y = cvt_pk_bf16(bf_lo(w.y) * r * g0[2], bf_hi(w.y) * r * g0[3]);
    o.z = cvt_pk_bf16(bf_lo(w.z) * r * g1[0], bf_hi(w.z) * r * g1[1]); o.w = cvt_pk_bf16(bf_lo(w.w) * r * g1[2], bf_hi(w.w) * r * g1[3]); return o;
}

struct MixArgs { const bf16_t* Z; const float* biasT; const float* qg; const float* kg; const float* sink; const float* vgain; const float* ws; const float* bs; bf16_t* AG; float* SS; const float* VSS; };

struct ConvJob { const float* w1; const float* w2; bf16_t* w1t; bf16_t* w2t; int next, stride; };
constexpr int CONV_BLOCKS = 2 * 32768;
__device__ __forceinline__ void conv_load(const ConvJob& J, int idx, f32x4 (&v)[8], int lane) {
    const bool second = idx >= 32768; const int r = idx & 32767;
    const float* W = second ? J.w2 : J.w1; const int N = second ? D : FF, nb = second ? 128 : 512;
    const int k0 = 64 * (r / nb), n0 = 32 * (r % nb);
    const float* p = W + (size_t)(k0 + 8 * (lane >> 3)) * N + n0 + 4 * (lane & 7);
#pragma unroll
    for (int i = 0; i < 8; ++i) v[i] = __builtin_nontemporal_load((const f32x4*)(p + (size_t)i * N));
}
__device__ __forceinline__ void conv_store(const ConvJob& J, int idx, const f32x4 (&v)[8], int lane) {
    const bool second = idx >= 32768; const int r = idx & 32767;
    bf16_t* WT = second ? J.w2t : J.w1t; const int ldt = second ? LDK16 : LDK4, nb = second ? 128 : 512;
    const int k0 = 64 * (r / nb), n0 = 32 * (r % nb);
    bf16_t* q = WT + (size_t)(n0 + 4 * (lane & 7)) * ldt + k0 + 8 * (lane >> 3);
#pragma unroll
    for (int j = 0; j < 4; ++j) { u32x4 o; o.x = cvt_pk_bf16(v[0][j], v[1][j]); o.y = cvt_pk_bf16(v[2][j], v[3][j]); o.z = cvt_pk_bf16(v[4][j], v[5][j]); o.w = cvt_pk_bf16(v[6][j], v[7][j]);
        __builtin_nontemporal_store(o, (u32x4*)(q + (size_t)j * ldt)); }
}
#define MIX_LDS_BARRIER() do { asm volatile("s_waitcnt lgkmcnt(0)" ::: "memory"); __builtin_amdgcn_s_barrier(); asm volatile("" ::: "memory"); } while (0)
constexpr int KV_BUF = V_OFF + 32768;
constexpr int BT_OFF = 2 * KV_BUF;
constexpr int RN_OFF = BT_OFF + 2048;
static_assert(RN_OFF + 1024 <= 147456, "mixer LDS map");

__device__ __forceinline__ void attn_stream(LAS unsigned char* lds, const MixArgs& A, ConvJob& J, int vcu, int G, int tid, int wid, int lane) {
    constexpr int NU = BATCH * NBLK * 16;
    constexpr float L2E = 1.4426950408889634f;
    const int fr = lane & 15, fq = lane >> 4, skey = tid >> 2, spart = tid & 3, arow = 16 * wid + fr;
    LAS float* bt = (LAS float*)(lds + BT_OFF);
    if (vcu >= NU) return;
    int u = vcu, h = u & 15, bb = u >> 4, b = bb / NBLK, blk = bb % NBLK;
    int kb = (blk == 0) ? 1 : 0, khi = (blk == NBLK - 1) ? 1 : 2;
    int bt_head = -1;
    u32x4 kr[4], vr[4], qraw[4];
#define ATT_LOADKV(b_, blk_, kb_, h_) do { const bf16_t* kp_ = A.Z + ((size_t)(b_) * SEQ + (size_t)((blk_) - 1 + (kb_)) * 128 + skey) * INW + O_K + ((h_) >> 2) * 128 + 8 * spart; \
        _Pragma("unroll") for (int i = 0; i < 4; ++i) { kr[i] = *(const u32x4*)(kp_ + 32 * i); vr[i] = *(const u32x4*)(kp_ + (O_V - O_K) + 32 * i); } } while (0)
#define ATT_LOADQ(b_, blk_, h_) do { const bf16_t* qp_ = A.Z + ((size_t)(b_) * SEQ + (size_t)(blk_) * 128 + arow) * INW + (h_) * 128 + 8 * fq; \
        _Pragma("unroll") for (int s = 0; s < 4; ++s) qraw[s] = *(const u32x4*)(qp_ + 32 * s); } while (0)
#define ATT_WRITEKV(buf_) do { float ss_ = 0.f; _Pragma("unroll") for (int i = 0; i < 4; ++i) ss_ += sumsq8(kr[i]); \
        ss_ += __shfl_xor(ss_, 1); ss_ += __shfl_xor(ss_, 2); \
        if (spart == 0) ((LAS float*)(lds + RN_OFF))[(buf_) * 128 + skey] = 1.0f / sqrtf(ss_ * (1.0f / 128.0f) + EPS); \
        _Pragma("unroll") for (int i = 0; i < 4; ++i) { *(LAS u32x4*)(lds + (buf_) * KV_BUF + K_OFF + skey * KSTR + (4 * i + spart) * 16) = kr[i]; \
            *(LAS u32x4*)(lds + (buf_) * KV_BUF + V_OFF + offb(skey, 4 * i + spart)) = vr[i]; } } while (0)
    ATT_LOADKV(b, blk, kb, h); ATT_LOADQ(b, blk, h);
    __syncthreads();
    ATT_WRITEKV(0);
    int buf = 0; bool first = true;
    bf16x8 qf[4]; float mrun = 0.f, lpart = 0.f, sinkv = 0.f; f32x4 oacc[8];
    for (;;) {
        if (first) {
            if (h != bt_head) { __syncthreads(); if (tid < 511) { const int idx = tid - 127; bt[tid] = (idx >= 0 && idx <= 256) ? A.biasT[h * 260 + idx] : -1e30f; } bt_head = h; }
            float ss = 0.f;
#pragma unroll
            for (int s = 0; s < 4; ++s) ss += sumsq8(qraw[s]);
            ss += __shfl_xor(ss, 16); ss += __shfl_xor(ss, 32);
            const float rn = (1.0f / sqrtf(ss * (1.0f / 128.0f) + EPS)) * 0.08838834764831845f;
#pragma unroll
            for (int s = 0; s < 4; ++s) {
                const f32x4 g0 = *(const f32x4*)(A.qg + 32 * s + 8 * fq) * *(const f32x4*)(A.kg + 32 * s + 8 * fq), g1 = *(const f32x4*)(A.qg + 32 * s + 8 * fq + 4) * *(const f32x4*)(A.kg + 32 * s + 8 * fq + 4);
                const u32x4 w = qraw[s]; u32x4 o;
                o.x = cvt_pk_bf16(bf_lo(w.x) * rn * g0[0], bf_hi(w.x) * rn * g0[1]); o.y = cvt_pk_bf16(bf_lo(w.y) * rn * g0[2], bf_hi(w.y) * rn * g0[3]);
                o.z = cvt_pk_bf16(bf_lo(w.z) * rn * g1[0], bf_hi(w.z) * rn * g1[1]); o.w = cvt_pk_bf16(bf_lo(w.w) * rn * g1[2], bf_hi(w.w) * rn * g1[3]);
                qf[s] = __builtin_bit_cast(bf16x8, o); }
            sinkv = A.sink[h]; mrun = sinkv; lpart = 0.f;
#pragma unroll
            for (int c = 0; c < 8; ++c) oacc[c] = (f32x4){0.f, 0.f, 0.f, 0.f};
        }
        MIX_LDS_BARRIER();
        int nkb = kb + 1, nu = u, nh = h, nb_ = b, nblk = blk, nkhi = khi; bool nfirst = false, nvalid = true;
        if (nkb > khi) { nu = u + G; nfirst = true;
            if (nu < NU) { nh = nu & 15; const int nbb = nu >> 4; nb_ = nbb / NBLK; nblk = nbb % NBLK; nkb = (nblk == 0) ? 1 : 0; nkhi = (nblk == NBLK - 1) ? 1 : 2; } else nvalid = false; }
        const bool last = (kb == khi);
        if (nvalid) { ATT_LOADKV(nb_, nblk, nkb, nh); if (nfirst) ATT_LOADQ(nb_, nblk, nh); }
        f32x4 cv[8]; const int cidx = J.next; const bool cdo = cidx < CONV_BLOCKS;
        if (cdo) conv_load(J, cidx, cv, lane);
        LAS unsigned char* kbase = lds + buf * KV_BUF + K_OFF; LAS unsigned char* vbase = lds + buf * KV_BUF + V_OFF;
        f32x4 sacc[8];
#pragma unroll
        for (int kt = 0; kt < 8; ++kt) { sacc[kt] = (f32x4){0.f, 0.f, 0.f, 0.f};
#pragma unroll
            for (int s = 0; s < 4; ++s) { const bf16x8 a = *(const LAS bf16x8*)(kbase + (16 * kt + fr) * KSTR + (32 * s + 8 * fq) * 2);
                sacc[kt] = __builtin_amdgcn_mfma_f32_16x16x32_bf16(a, qf[s], sacc[kt], 0, 0, 0); } }
        float bm = -1e30f;
        {
            const LAS float* btp = bt + (kb * 128 + 4 * fq - arow + 127);
            const LAS f32x4* rnp = (const LAS f32x4*)(lds + RN_OFF) + buf * 32 + fq;
#pragma unroll
            for (int kt = 0; kt < 8; ++kt) { const f32x4 rk = rnp[4 * kt];
#pragma unroll
                for (int j = 0; j < 4; ++j) { const float v = sacc[kt][j] * rk[j] + btp[16 * kt + j]; sacc[kt][j] = v; bm = fmaxf(bm, v); } }
        }
        bm = fmaxf(bm, __shfl_xor(bm, 16)); bm = fmaxf(bm, __shfl_xor(bm, 32));
        const float mnew = fmaxf(mrun, bm), alpha = __builtin_amdgcn_exp2f((mrun - mnew) * L2E);
        mrun = mnew; lpart *= alpha;
#pragma unroll
        for (int c = 0; c < 8; ++c) oacc[c] = oacc[c] * alpha;
        const float moff = mnew * L2E;
        bf16x8 pf[4];
#pragma unroll
        for (int ks = 0; ks < 4; ++ks) { float p[8];
#pragma unroll
            for (int j = 0; j < 4; ++j) { p[j] = __builtin_amdgcn_exp2f(sacc[2 * ks][j] * L2E - moff); p[4 + j] = __builtin_amdgcn_exp2f(sacc[2 * ks + 1][j] * L2E - moff); }
            lpart += ((p[0] + p[1]) + (p[2] + p[3])) + ((p[4] + p[5]) + (p[6] + p[7]));
            u32x4 w; w.x = cvt_pk_bf16(p[0], p[1]); w.y = cvt_pk_bf16(p[2], p[3]); w.z = cvt_pk_bf16(p[4], p[5]); w.w = cvt_pk_bf16(p[6], p[7]);
            pf[ks] = __builtin_bit_cast(bf16x8, w); }
#pragma unroll
        for (int ks = 0; ks < 4; ++ks)
#pragma unroll
            for (int c = 0; c < 8; ++c) { const bf16x8 a = tr_frag(vbase, 32 * ks, c, lane);
                oacc[c] = __builtin_amdgcn_mfma_f32_16x16x32_bf16(a, pf[ks], oacc[c], 0, 0, 0); }
        if (last) {
            float l = lpart; l += __shfl_xor(l, 16); l += __shfl_xor(l, 32);
            l += __builtin_amdgcn_exp2f((sinkv - mrun) * L2E);
            const float inv = 1.0f / l;
            const size_t tok = (size_t)b * SEQ + (size_t)blk * 128 + arow;
            bf16_t* op = A.AG + tok * MIXW + h * 128 + 4 * fq;
            float ssq = 0.f;
#pragma unroll
            for (int c = 0; c < 8; ++c) { const f32x4 o = oacc[c] * inv; ssq += (o[0] * o[0] + o[1] * o[1]) + (o[2] * o[2] + o[3] * o[3]);
                u32x2 w; w.x = cvt_pk_bf16(o[0], o[1]); w.y = cvt_pk_bf16(o[2], o[3]); *(u32x2*)(op + 16 * c) = w; }
            ssq += __shfl_xor(ssq, 16); ssq += __shfl_xor(ssq, 32);
            if (fq == 0) A.SS[tok * 32 + h] = ssq;
        }
        if (nvalid) {
            ATT_WRITEKV(buf ^ 1);
        }
        if (cdo) { conv_store(J, cidx, cv, lane); J.next = cidx + J.stride; }
        if (!nvalid) break;
        buf ^= 1; kb = nkb; u = nu; h = nh; b = nb_; blk = nblk; khi = nkhi; first = nfirst;
    }
#undef ATT_LOADKV
#undef ATT_LOADQ
#undef ATT_WRITEKV
}

__device__ __forceinline__ void gmlp_stream(LAS unsigned char* lds, const MixArgs& A, ConvJob& J, int vcu, int G, int tid, int wid, int lane) {
    constexpr int NU = BATCH * NBLK * 16;
    const int fr = lane & 15, fq = lane >> 4, skey = tid >> 2, spart = tid & 3, trow = 16 * wid + fr;
    if (vcu >= NU) return;
    int u = vcu, hh = u & 15, bb = u >> 4;
    u32x4 vr[4]; f32x4 pa, pb;
#define GM_LOADV(bb_, hh_) do { const size_t t_ = (size_t)(bb_) * 128 + skey; const bf16_t* vp_ = A.Z + t_ * INW + O_G + (hh_) * 128 + 8 * spart; \
        _Pragma("unroll") for (int i = 0; i < 4; ++i) vr[i] = *(const u32x4*)(vp_ + 32 * i); \
        pa = *(const f32x4*)(A.VSS + t_ * 32 + 8 * spart); pb = *(const f32x4*)(A.VSS + t_ * 32 + 8 * spart + 4); } while (0)
#define GM_WRITEV(buf_, hh_) do { float ss_ = ((pa[0] + pa[1]) + (pa[2] + pa[3])) + ((pb[0] + pb[1]) + (pb[2] + pb[3])); \
        ss_ += __shfl_xor(ss_, 1); ss_ += __shfl_xor(ss_, 2); const float rn_ = 1.0f / sqrtf(ss_ * (1.0f / 2048.0f) + EPS); \
        _Pragma("unroll") for (int i = 0; i < 4; ++i) *(LAS u32x4*)(lds + (buf_) * KV_BUF + V_OFF + offb(skey, 4 * i + spart)) = scale8(vr[i], rn_, A.vgain + (hh_) * 128 + 32 * i + 8 * spart); } while (0)
    GM_LOADV(bb, hh);
    __syncthreads();
    GM_WRITEV(0, hh);
    int buf = 0, w_head = -1; bf16x8 wf[4]; float bsv = 0.f;
    for (;;) {
        if (hh != w_head) {
            const float* wp = A.ws + ((size_t)hh * 128 + trow) * 128 + 4 * fq;
#pragma unroll
            for (int ks = 0; ks < 4; ++ks) { const f32x4 a = *(const f32x4*)(wp + 32 * ks), c = *(const f32x4*)(wp + 32 * ks + 16);
                u32x4 w; w.x = cvt_pk_bf16(a[0], a[1]); w.y = cvt_pk_bf16(a[2], a[3]); w.z = cvt_pk_bf16(c[0], c[1]); w.w = cvt_pk_bf16(c[2], c[3]);
                wf[ks] = __builtin_bit_cast(bf16x8, w); }
            bsv = A.bs[hh * 128 + trow]; w_head = hh;
        }
        MIX_LDS_BARRIER();
        const int nu = u + G; const bool nvalid = nu < NU; const int nhh = nu & 15, nbb = nu >> 4;
        if (nvalid) GM_LOADV(nbb, nhh);
        f32x4 cv[8]; const int cidx = J.next; const bool cdo = cidx < CONV_BLOCKS;
        if (cdo) conv_load(J, cidx, cv, lane);
        const size_t tok = (size_t)bb * 128 + trow;
        const bf16_t* up = A.Z + tok * INW + O_U + hh * 128 + 4 * fq;
        u32x2 uu[8];
#pragma unroll
        for (int c = 0; c < 8; ++c) uu[c] = *(const u32x2*)(up + 16 * c);
        LAS unsigned char* vbase = lds + buf * KV_BUF + V_OFF;
        f32x4 acc[8];
#pragma unroll
        for (int c = 0; c < 8; ++c) acc[c] = (f32x4){0.f, 0.f, 0.f, 0.f};
#pragma unroll
        for (int ks = 0; ks < 4; ++ks)
#pragma unroll
            for (int c = 0; c < 8; ++c) { const bf16x8 a = tr_frag(vbase, 32 * ks, c, lane);
                acc[c] = __builtin_amdgcn_mfma_f32_16x16x32_bf16(a, wf[ks], acc[c], 0, 0, 0); }
        bf16_t* op = A.AG + tok * MIXW + 2048 + hh * 128 + 4 * fq;
        float ssq = 0.f;
#pragma unroll
        for (int c = 0; c < 8; ++c) {
            f32x4 o; o[0] = bf_lo(uu[c].x) * (acc[c][0] + bsv); o[1] = bf_hi(uu[c].x) * (acc[c][1] + bsv); o[2] = bf_lo(uu[c].y) * (acc[c][2] + bsv); o[3] = bf_hi(uu[c].y) * (acc[c][3] + bsv);
            ssq += (o[0] * o[0] + o[1] * o[1]) + (o[2] * o[2] + o[3] * o[3]);
            u32x2 w; w.x = cvt_pk_bf16(o[0], o[1]); w.y = cvt_pk_bf16(o[2], o[3]); *(u32x2*)(op + 16 * c) = w; }
        ssq += __shfl_xor(ssq, 16); ssq += __shfl_xor(ssq, 32);
        if (fq == 0) A.SS[tok * 32 + 16 + hh] = ssq;
        if (nvalid) GM_WRITEV(buf ^ 1, nhh);
        if (cdo) { conv_store(J, cidx, cv, lane); J.next = cidx + J.stride; }
        if (!nvalid) break;
        buf ^= 1; u = nu; hh = nhh; bb = nbb;
    }
#undef GM_LOADV
#undef GM_WRITEV
}
}

struct Args {
    const float *x, *norm1, *w_in, *q_gain, *k_gain, *rel_bias, *attn_sink, *attn_out_gain, *gmlp_v_gain, *gmlp_w_s, *gmlp_b_s, *gmlp_out_gain, *w_out, *norm2, *w1, *w2;
    float* out; unsigned char* ws; int ph_lo, ph_hi;
};
constexpr int N_PHASES = 7;

__global__ void __launch_bounds__(NWAVES * 64, 2) fwd_mega(Args args) {
    extern __shared__ __attribute__((aligned(16))) unsigned char lds_raw[];
    LAS unsigned char* lds = (LAS unsigned char*)lds_raw;
    const int tid = threadIdx.x, lane = tid & 63, wave = __builtin_amdgcn_readfirstlane(tid >> 6);
    const int G = gridDim.x, bx = blockIdx.x;
    const int vcu = (G % 8 == 0) ? (bx % 8) * (G / 8) + bx / 8 : bx;
    unsigned char* ws = args.ws;
    bf16_t* Win_t = (bf16_t*)(ws + WS_WIN); bf16_t* Wout_t = (bf16_t*)(ws + WS_WOUT); bf16_t* W1_t = (bf16_t*)(ws + WS_W1); bf16_t* W2_t = (bf16_t*)(ws + WS_W2);
    bf16_t* XN = (bf16_t*)(ws + WS_XN); bf16_t* Z = (bf16_t*)(ws + WS_Z); bf16_t* AG = (bf16_t*)(ws + WS_AG); bf16_t* HID = (bf16_t*)(ws + WS_HID);
    float* biasT = (float*)(ws + WS_BIAS); float* SS = (float*)(ws + WS_SS); float* RSS = (float*)(ws + WS_RSS); float* VSS = (float*)(ws + WS_VSS);
    const int lo = args.ph_lo, hi = args.ph_hi;
#define IN(k) (lo <= (k) && (k) < hi)
#define SEAM(k) do { if (IN(k) && IN((k) + 1)) cg::this_grid().sync(); } while (0)

    if (IN(0)) {
        const int gw = vcu * NWAVES + wave, NGW = G * NWAVES;
        constexpr int B_IN = (D / 64) * (INW / 32), B_OUT = (MIXW / 64) * (D / 32), NBLK0 = B_IN + B_OUT;
        auto blk_load = [&](int it, f32x4 (&v)[8]) {
            const bool second = it >= B_IN; const int r = second ? it - B_IN : it;
            const float* W = second ? args.w_out : args.w_in; const int N = second ? D : INW, nb = N / 32;
            const float* p = W + (size_t)(64 * (r / nb) + 8 * (lane >> 3)) * N + 32 * (r % nb) + 4 * (lane & 7);
#pragma unroll
            for (int i = 0; i < 8; ++i) v[i] = __builtin_nontemporal_load((const f32x4*)(p + (size_t)i * N));
        };
        auto blk_store = [&](int it, f32x4 (&v)[8]) {
            const bool second = it >= B_IN; const int r = second ? it - B_IN : it;
            bf16_t* WT = second ? Wout_t : Win_t; const int nb = (second ? D : INW) / 32;
            const int k0 = 64 * (r / nb) + 8 * (lane >> 3), n0 = 32 * (r % nb) + 4 * (lane & 7);
            if (second) {
                const float* gp = (k0 < 2048) ? args.attn_out_gain + k0 : args.gmlp_out_gain + (k0 - 2048);
                const f32x4 g0 = *(const f32x4*)gp, g1 = *(const f32x4*)(gp + 4);
#pragma unroll
                for (int i = 0; i < 4; ++i) { v[i] = v[i] * g0[i]; v[4 + i] = v[4 + i] * g1[i]; }
            }
            bf16_t* q = WT + (size_t)n0 * LDK4 + k0;
#pragma unroll
            for (int j = 0; j < 4; ++j) { u32x4 o; o.x = cvt_pk_bf16(v[0][j], v[1][j]); o.y = cvt_pk_bf16(v[2][j], v[3][j]); o.z = cvt_pk_bf16(v[4][j], v[5][j]); o.w = cvt_pk_bf16(v[6][j], v[7][j]);
                *(u32x4*)(q + (size_t)j * LDK4) = o; }
        };
        {
            f32x4 va[8], vb[8]; int it = gw;
            if (it < NBLK0) blk_load(it, va);
            while (it < NBLK0) {
                const int n1 = it + NGW; if (n1 < NBLK0) blk_load(n1, vb);
                blk_store(it, va);
                if (n1 >= NBLK0) break;
                const int n2 = n1 + NGW; if (n2 < NBLK0) blk_load(n2, va);
                blk_store(n1, vb);
                it = n2;
            }
        }
        {
            f32x4 va[16], vb[16]; int m = gw;
            if (m < M) p0_row_load(args.x + (size_t)m * D, va, lane);
            while (m < M) {
                const int m1 = m + NGW; if (m1 < M) p0_row_load(args.x + (size_t)m1 * D, vb, lane);
                p0_row_store(va, args.norm1, XN + (size_t)m * LDK4, lane);
                if (m1 >= M) break;
                const int m2 = m1 + NGW; if (m2 < M) p0_row_load(args.x + (size_t)m2 * D, va, lane);
                p0_row_store(vb, args.norm1, XN + (size_t)m1 * LDK4, lane);
                m = m2;
            }
        }
        for (int e = (vcu * NWAVES * 64 + tid) * 4; e < M * 16; e += G * NWAVES * 64 * 4) *(f32x4*)(RSS + e) = (f32x4){0.f, 0.f, 0.f, 0.f};
        if (bx == 0) for (int e = tid; e < 16 * 257; e += NWAVES * 64) { const int h = e / 257, idx = e % 257; biasT[h * 260 + idx] = args.rel_bias[t5_bucket_dev(idx - 128) * 16 + h]; }
    }
    SEAM(0);
    if (IN(1)) {
        pg8::Gemm g{XN, Win_t, M, INW, D, LDK4, LDK4}; pg8::StaticOrder S; S.init(M, INW, G, bx);
        pg8::EpiZ E{Z, INW, O_U, VSS, O_G, lds + pg8::STAGE_BYTES + wave * 2048};
        pg8::gemm_phase<pg8::EpiZ, pg8::StaticOrder, true, true>(lds, g, S, E);
    }
    SEAM(1);
    if (IN(2)) {
        const mixp::MixArgs A{Z, biasT, args.q_gain, args.k_gain, args.attn_sink, args.gmlp_v_gain, args.gmlp_w_s, args.gmlp_b_s, AG, SS, VSS};
        mixp::ConvJob J{args.w1, args.w2, W1_t, W2_t, vcu * NWAVES + wave, G * NWAVES};
        mixp::attn_stream(lds, A, J, vcu, G, tid, wave, lane);
        mixp::gmlp_stream(lds, A, J, vcu, G, tid, wave, lane);
        while (J.next < mixp::CONV_BLOCKS) { f32x4 cv[8]; mixp::conv_load(J, J.next, cv, lane); mixp::conv_store(J, J.next, cv, lane); J.next += J.stride; }
    }
    SEAM(2);
    if (IN(4)) {
        pg8::Gemm g{AG, Wout_t, M, D, MIXW, MIXW, LDK4}; pg8::StaticOrder S; S.init(M, D, G, bx);
        pg8::EpiOut E{args.x, args.out, XN, args.norm2, RSS, SS, D, LDK4, lds + pg8::STAGE_BYTES + wave * 2048};
        pg8::gemm_phase<pg8::EpiOut, pg8::StaticOrder, true, true>(lds, g, S, E);
    }
    SEAM(4);
    if (IN(5)) {
        pg8::Gemm g{XN, W1_t, M, FF, D, LDK4, LDK4}; pg8::StaticOrder S; S.init(M, FF, G, bx);
        pg8::EpiHid E{HID, RSS, LDK16, lds + pg8::STAGE_BYTES + wave * 2048};
        pg8::gemm_phase<pg8::EpiHid, pg8::StaticOrder, true, true>(lds, g, S, E);
    }
    SEAM(5);
    if (IN(6)) {
        pg8::Gemm g{HID, W2_t, M, D, FF, LDK16, LDK16}; pg8::StaticOrder S; S.init(M, D, G, bx);
        pg8::EpiFinal E{args.out, D, XN, LDK4, args.norm2, lds + pg8::STAGE_BYTES + wave * 2048};
        pg8::gemm_phase<pg8::EpiFinal, pg8::StaticOrder, true, true>(lds, g, S, E);
    }
#undef IN
#undef SEAM
}

extern "C" void kernel_launch(void* const* d_in, const int* in_sizes, int n_in, void* d_out, int out_size, void* d_ws, size_t ws_size, hipStream_t stream) {
    static int grid = 0;
    if (grid == 0) {
        if (n_in != 16 || in_sizes[0] != M * D || out_size != M * D || ws_size < WS_END) { fprintf(stderr, "kernel_launch: unexpected shapes (n_in %d, in0 %d, out %d, ws %zu); nothing launched\n", n_in, n_in > 0 ? in_sizes[0] : -1, out_size, ws_size); grid = -1; return; }
        int dev = 0, cus = 0, per_cu = 0;
        if (hipGetDevice(&dev) != hipSuccess || hipDeviceGetAttribute(&cus, hipDeviceAttributeMultiprocessorCount, dev) != hipSuccess) { grid = -1; return; }
        if (hipFuncSetAttribute((const void*)fwd_mega, hipFuncAttributeMaxDynamicSharedMemorySize, LDS_BYTES) != hipSuccess) { fprintf(stderr, "kernel_launch: hipFuncSetAttribute failed\n"); grid = -1; return; }
        if (hipOccupancyMaxActiveBlocksPerMultiprocessor(&per_cu, (const void*)fwd_mega, NWAVES * 64, LDS_BYTES) != hipSuccess || per_cu < 1) { fprintf(stderr, "kernel_launch: occupancy query says %d blocks/CU\n", per_cu); per_cu = 1; }
        (void)hipGetLastError();
        grid = cus;
    }
    if (grid < 0) return;
    Args a{};
    a.x = (const float*)d_in[0]; a.norm1 = (const float*)d_in[1]; a.w_in = (const float*)d_in[2]; a.q_gain = (const float*)d_in[3]; a.k_gain = (const float*)d_in[4];
    a.rel_bias = (const float*)d_in[5]; a.attn_sink = (const float*)d_in[6]; a.attn_out_gain = (const float*)d_in[7]; a.gmlp_v_gain = (const float*)d_in[8];
    a.gmlp_w_s = (const float*)d_in[9]; a.gmlp_b_s = (const float*)d_in[10]; a.gmlp_out_gain = (const float*)d_in[11]; a.w_out = (const float*)d_in[12];
    a.norm2 = (const float*)d_in[13]; a.w1 = (const float*)d_in[14]; a.w2 = (const float*)d_in[15];
    a.out = (float*)d_out; a.ws = (unsigned char*)d_ws;
#if MK_N_LAUNCHES == 1
    a.ph_lo = 0; a.ph_hi = N_PHASES;
    void* kargs[] = {&a};
    hipError_t e = hipLaunchCooperativeKernel((const void*)fwd_mega, dim3(grid), dim3(NWAVES * 64), kargs, LDS_BYTES, stream);
    if (e != hipSuccess) fprintf(stderr, "kernel_launch: cooperative launch failed: %s (grid %d)\n", hipGetErrorString(e), grid);
#else
    for (int ph = 0; ph < N_PHASES; ++ph) {
        a.ph_lo = ph; a.ph_hi = ph + 1;
        hipLaunchKernelGGL(fwd_mega, dim3(grid), dim3(NWAVES * 64), LDS_BYTES, stream, a);
    }
#endif
}
```
